# Optimizing an MI355X kernel written in HIP

```python
import jax
import jax.numpy as jnp
from jax import lax
import numpy as np

D_MODEL = 1024
BATCH = 4
SEQ = 4096
DEPTH = 2

A_HEAD_DIM = 64
A_WIDTH = D_MODEL // 2
A_HEADS = A_WIDTH // A_HEAD_DIM
MOBA_BLOCK = 256
MOBA_TOPK = 3
MOBA_Q_CHUNK = 32
B_WIDTH = D_MODEL // 2
B_HEADS = 4
B_HEAD_DIM = B_WIDTH // B_HEADS
B_QKV_BLOCK = 4
B_CONV = 4
MLSTM_CHUNK = 64
C_WIDTH = D_MODEL
C_GROUPS = 8
C_CHUNK = 128
IN_WIDTH = 4 * A_WIDTH + 2 * B_WIDTH
MIX_WIDTH = A_WIDTH + B_WIDTH
N_EVEN = (DEPTH + 1) // 2
N_ODD = DEPTH // 2
NEG = -1e30

kernel_name = "hybrid_moba_mlstm_gmlp_block"


def _rms_norm(x, g, eps=1e-6):
    xf = x.astype(jnp.float32)
    y = xf * lax.rsqrt(jnp.mean(xf * xf, axis=-1, keepdims=True) + eps)
    return (y * g.astype(jnp.float32)).astype(x.dtype)


def _layer_norm(x, eps=1e-5):
    xf = x.astype(jnp.float32)
    mu = jnp.mean(xf, axis=-1, keepdims=True)
    var = jnp.mean(jnp.square(xf - mu), axis=-1, keepdims=True)
    return (xf - mu) * lax.rsqrt(var + eps)


def _heads(t, n):
    b, s, _ = t.shape
    return t.reshape(b, s, n, -1).transpose(0, 2, 1, 3)


def _merge(t):
    b, h, s, d = t.shape
    return t.transpose(0, 2, 1, 3).reshape(b, s, h * d)


def _moba(q, k, v):
    b, h, s, dh = q.shape
    nb = -(-s // MOBA_BLOCK)
    pad = nb * MOBA_BLOCK - s
    kp = jnp.pad(k, ((0, 0), (0, 0), (0, pad), (0, 0)))
    vp = jnp.pad(v, ((0, 0), (0, 0), (0, pad), (0, 0)))
    kb = kp.reshape(b, h, nb, MOBA_BLOCK, dh)
    vb = vp.reshape(b, h, nb, MOBA_BLOCK, dh)
    kmean = jnp.mean(kb.astype(jnp.float32), axis=3)
    qblk = jnp.arange(s) // MOBA_BLOCK
    score = jnp.einsum('bhsd,bhnd->bhsn', q.astype(jnp.float32), kmean)
    past = jnp.arange(nb)[None, :] < qblk[:, None]
    score = jnp.where(past, score, NEG)
    topk = min(MOBA_TOPK, nb)
    _, idx = lax.top_k(score, topk)
    valid = idx < qblk[:, None]
    nq = s // MOBA_Q_CHUNK

    def chunks(t):
        return jnp.moveaxis(t.reshape(b, h, nq, MOBA_Q_CHUNK, *t.shape[3:]), 2, 0)

    gather = jax.vmap(jax.vmap(lambda blocks, ix: blocks[ix]))
    scale = dh ** -0.5

    def step(args):
        qc, ic, vmask, cid = args
        q0 = cid * MOBA_Q_CHUNK
        j = q0 // MOBA_BLOCK
        qpos = q0 + jnp.arange(MOBA_Q_CHUNK)
        k_sel = gather(kb, ic)
        v_sel = gather(vb, ic)
        k_own = lax.dynamic_slice_in_dim(kp, j * MOBA_BLOCK, MOBA_BLOCK, axis=2)
        v_own = lax.dynamic_slice_in_dim(vp, j * MOBA_BLOCK, MOBA_BLOCK, axis=2)
        l_sel = jnp.einsum('bhqd,bhqtkd->bhqtk', qc, k_sel).astype(jnp.float32) * scale
        l_sel = jnp.where(vmask[..., None], l_sel, NEG).reshape(b, h, MOBA_Q_CHUNK, topk * MOBA_BLOCK)
        kpos = j * MOBA_BLOCK + jnp.arange(MOBA_BLOCK)
        l_own = jnp.einsum('bhqd,bhkd->bhqk', qc, k_own).astype(jnp.float32) * scale
        l_own = jnp.where(kpos[None, :] <= qpos[:, None], l_own, NEG)
        p = jax.nn.softmax(jnp.concatenate([l_sel, l_own], axis=-1), axis=-1).astype(v.dtype)
        p_sel = p[..., :topk * MOBA_BLOCK].reshape(b, h, MOBA_Q_CHUNK, topk, MOBA_BLOCK)
        p_own = p[..., topk * MOBA_BLOCK:]
        return (jnp.einsum('bhqtk,bhqtkd->bhqd', p_sel, v_sel)
                + jnp.einsum('bhqk,bhkd->bhqd', p_own, v_own))

    out = lax.map(step, (chunks(q), chunks(idx), chunks(valid), jnp.arange(nq)))
    return jnp.moveaxis(out, 0, 2).reshape(b, h, s, dh)


def _mlstm(q, k, v, ig, fg):
    dtype = q.dtype
    b, h, s, dh = q.shape
    L = MLSTM_CHUNK
    nc = s // L
    q = q.astype(jnp.float32)
    k = k.astype(jnp.float32) * (dh ** -0.5)
    v = v.astype(jnp.float32)
    ig = ig.astype(jnp.float32)
    lf = jax.nn.log_sigmoid(fg.astype(jnp.float32))

    def chunks(t):
        return jnp.moveaxis(t.reshape(b, h, nc, L, *t.shape[3:]), 2, 0)

    tri = jnp.tril(jnp.ones((L, L), dtype=bool))

    def step(carry, xs):
        C, n, m = carry
        qc, kc, vc, ic, lc = xs
        cum = jnp.cumsum(lc, axis=-1)
        tot = cum[..., -1]
        dmat = jnp.where(tri, cum[..., :, None] - cum[..., None, :] + ic[..., None, :], NEG)
        g = cum + m[..., None]
        m_t = jnp.maximum(g, jnp.max(dmat, axis=-1))
        w_intra = jnp.einsum('bhtd,bhsd->bhts', qc, kc) * jnp.exp(dmat - m_t[..., None])
        w_inter = jnp.exp(g - m_t)
        num = (w_inter[..., None] * jnp.einsum('bhvk,bhtk->bhtv', C, qc)
               + jnp.einsum('bhts,bhsv->bhtv', w_intra, vc))
        den = w_inter * jnp.einsum('bhk,bhtk->bht', n, qc) + jnp.sum(w_intra, axis=-1)
        hc = num / jnp.maximum(jnp.abs(den), jnp.exp(-m_t))[..., None]
        w_state = tot[..., None] - cum + ic
        m_new = jnp.maximum(tot + m, jnp.max(w_state, axis=-1))
        decay = jnp.exp(tot + m - m_new)
        ws = jnp.exp(w_state - m_new[..., None])
        C = decay[..., None, None] * C + jnp.einsum('bhs,bhsv,bhsk->bhvk', ws, vc, kc)
        n = decay[..., None] * n + jnp.einsum('bhs,bhsk->bhk', ws, kc)
        return (C, n, m_new), hc

    init = (jnp.zeros((b, h, dh, dh), jnp.float32), jnp.zeros((b, h, dh), jnp.float32),
            jnp.zeros((b, h), jnp.float32))
    _, hs = lax.scan(step, init, (chunks(q), chunks(k), chunks(v), chunks(ig), chunks(lf)))
    return jnp.moveaxis(hs, 0, 2).reshape(b, h, s, dh).astype(dtype)


def _causal_conv(x, w, bias):
    ch = x.shape[-1]
    y = lax.conv_general_dilated(x, w[:, None, :].astype(x.dtype), window_strides=(1,),
                                 padding=[(B_CONV - 1, 0)], dimension_numbers=('NWC', 'WIO', 'NWC'),
                                 feature_group_count=ch)
    return y + bias


def _headwise(x, w):
    b, s, d = x.shape
    nblk, blk, _ = w.shape
    return jnp.einsum('bsgi,gio->bsgo', x.reshape(b, s, nblk, blk), w).reshape(b, s, d)


def _even_mixer(h, w_in, w_out, q_g, k_g, conv_w, conv_b, wq, wk, wv, w_gates, b_gates, out_g, skip):
    proj = h @ w_in
    aq, ak, av, az, bx, bz = jnp.split(
        proj, [A_WIDTH, 2 * A_WIDTH, 3 * A_WIDTH, 4 * A_WIDTH, 4 * A_WIDTH + B_WIDTH], axis=-1)
    q = _rms_norm(_heads(aq, A_HEADS), q_g)
    k = _rms_norm(_heads(ak, A_HEADS), k_g)
    ya = _merge(_moba(q, k, _heads(av, A_HEADS))) * jax.nn.silu(az)
    xc = jax.nn.silu(_causal_conv(bx, conv_w, conv_b))
    bq = _headwise(xc, wq)
    bk = _headwise(xc, wk)
    bv = _headwise(bx, wv)
    gates = jnp.concatenate([bq, bk, bv], axis=-1) @ w_gates + b_gates
    ig = gates[..., :B_HEADS].transpose(0, 2, 1)
    fg = gates[..., B_HEADS:].transpose(0, 2, 1)
    hb = _mlstm(_heads(bq, B_HEADS), _heads(bk, B_HEADS), _heads(bv, B_HEADS), ig, fg)
    hb = _merge(_layer_norm(hb).astype(h.dtype)) * out_g
    yb = (hb + skip * xc) * jax.nn.silu(bz)
    return jnp.concatenate([ya, yb], axis=-1) @ w_out


def _odd_mixer(h, w_in, w_out, ln_g, ln_b, ws, bs):
    b, s, _ = h.shape
    u, v, z = jnp.split(h @ w_in, [C_WIDTH, 2 * C_WIDTH], axis=-1)
    u = jax.nn.gelu(u)
    v = (_layer_norm(jax.nn.gelu(v)) * ln_g + ln_b).astype(h.dtype)
    nch = s // C_CHUNK
    vg = v.reshape(b, nch, C_CHUNK, C_GROUPS, C_WIDTH // C_GROUPS)
    wm = jnp.where(jnp.tril(jnp.ones((C_CHUNK, C_CHUNK), dtype=bool)), ws, 0.0)
    sg = jnp.einsum('gts,bnsgc->bntgc', wm, vg) + bs.T[:, :, None]
    y = u * sg.reshape(b, s, C_WIDTH) * jax.nn.silu(z)
    return y @ w_out


def setup_inputs(seed: int = 0) -> dict:
    key = jax.random.key(seed)
    ks = jax.random.split(key, 24)

    def nrm(k, shape, sc):
        return jax.random.normal(k, shape, jnp.float32) * sc

    nblk = B_WIDTH // B_QKV_BLOCK
    i_bias = nrm(ks[15], (N_EVEN, B_HEADS), 0.1)
    f_bias = jnp.linspace(3.0, 6.0, B_HEADS, dtype=jnp.float32)[None, :] + nrm(ks[16], (N_EVEN, B_HEADS), 0.1)
    return {
        "x": nrm(ks[0], (BATCH, SEQ, D_MODEL), 1.0),
        "c": nrm(ks[1], (BATCH, D_MODEL), 1.0),
        "ln_g": 1.0 + nrm(ks[2], (DEPTH, D_MODEL), 0.1),
        "ada_w": nrm(ks[3], (DEPTH, D_MODEL, 3 * D_MODEL), 0.5 * D_MODEL ** -0.5),
        "ada_b": nrm(ks[4], (DEPTH, 3 * D_MODEL), 0.02),
        "w_in": nrm(ks[5], (DEPTH, D_MODEL, IN_WIDTH), D_MODEL ** -0.5),
        "w_out": nrm(ks[6], (DEPTH, MIX_WIDTH, D_MODEL), MIX_WIDTH ** -0.5),
        "a_q_g": 1.0 + nrm(ks[7], (N_EVEN, A_HEAD_DIM), 0.1),
        "a_k_g": 1.0 + nrm(ks[8], (N_EVEN, A_HEAD_DIM), 0.1),
        "b_conv_w": nrm(ks[9], (N_EVEN, B_CONV, B_WIDTH), B_CONV ** -0.5),
        "b_conv_b": nrm(ks[10], (N_EVEN, B_WIDTH), 0.02),
        "b_wq": nrm(ks[11], (N_EVEN, nblk, B_QKV_BLOCK, B_QKV_BLOCK), B_QKV_BLOCK ** -0.5),
        "b_wk": nrm(ks[12], (N_EVEN, nblk, B_QKV_BLOCK, B_QKV_BLOCK), B_QKV_BLOCK ** -0.5),
        "b_wv": nrm(ks[13], (N_EVEN, nblk, B_QKV_BLOCK, B_QKV_BLOCK), B_QKV_BLOCK ** -0.5),
        "b_w_gates": nrm(ks[14], (N_EVEN, 3 * B_WIDTH, 2 * B_HEADS), (3 * B_WIDTH) ** -0.5),
        "b_b_gates": jnp.concatenate([i_bias, f_bias], axis=-1),
        "b_out_g": 1.0 + nrm(ks[17], (N_EVEN, B_WIDTH), 0.1),
        "b_skip": 1.0 + nrm(ks[18], (N_EVEN, B_WIDTH), 0.1),
        "c_ln_g": 1.0 + nrm(ks[19], (N_ODD, C_WIDTH), 0.1),
        "c_ln_b": nrm(ks[20], (N_ODD, C_WIDTH), 0.02),
        "c_ws": nrm(ks[21], (N_ODD, C_GROUPS, C_CHUNK, C_CHUNK), C_CHUNK ** -0.5),
        "c_bs": 1.0 + nrm(ks[22], (N_ODD, C_GROUPS, C_CHUNK), 0.1),
    }


def reference(x, c, ln_g, ada_w, ada_b, w_in, w_out, a_q_g, a_k_g, b_conv_w, b_conv_b, b_wq, b_wk,
              b_wv, b_w_gates, b_b_gates, b_out_g, b_skip, c_ln_g, c_ln_b, c_ws, c_bs):
    cs = jax.nn.silu(c)
    for layer in range(DEPTH):
        mod = cs @ ada_w[layer] + ada_b[layer]
        shift, scale, gate = jnp.split(mod, 3, axis=-1)
        h = _rms_norm(x, ln_g[layer]) * (1.0 + scale[:, None, :]) + shift[:, None, :]
        if layer % 2 == 0:
            e = layer // 2
            y = _even_mixer(h, w_in[layer], w_out[layer], a_q_g[e], a_k_g[e], b_conv_w[e], b_conv_b[e],
                            b_wq[e], b_wk[e], b_wv[e], b_w_gates[e], b_b_gates[e], b_out_g[e], b_skip[e])
        else:
            o = layer // 2
            y = _odd_mixer(h, w_in[layer], w_out[layer], c_ln_g[o], c_ln_b[o], c_ws[o], c_bs[o])
        x = x + gate[:, None, :] * y
    return x
```

```cpp
#include <hip/hip_runtime.h>
#include <hip/hip_cooperative_groups.h>
#include <stdint.h>
#include <cstdio>
#include <type_traits>
namespace cg = cooperative_groups;
#define DI __device__ __forceinline__

#ifndef MK_FUSED
#define MK_FUSED 1
#endif

typedef unsigned short bfu;
typedef short bf16x8 __attribute__((ext_vector_type(8)));
typedef float f32x16 __attribute__((ext_vector_type(16)));
typedef float f32x2 __attribute__((ext_vector_type(2)));
typedef __bf16 bf16x2v __attribute__((ext_vector_type(2)));
typedef unsigned u32x4 __attribute__((ext_vector_type(4)));
typedef unsigned u32x2 __attribute__((ext_vector_type(2)));

#define MFMA(a, b, c) __builtin_amdgcn_mfma_f32_32x32x16_bf16((a), (b), (c), 0, 0, 0)

DI unsigned pack2(float a, float b) { f32x2 v = {a, b}; bf16x2v r = __builtin_convertvector(v, bf16x2v); return __builtin_bit_cast(unsigned, r); }
DI float bflo(unsigned u) { return __uint_as_float(u << 16); }
DI float bfhi(unsigned u) { return __uint_as_float(u & 0xffff0000u); }
DI bfu f2bf(float a) { return (bfu)(pack2(a, 0.f) & 0xffffu); }
DI float bf2f(bfu h) { return __uint_as_float(((unsigned)h) << 16); }
DI int tid_l() { int t = threadIdx.x; asm volatile("" : "+v"(t)); return t; }
DI int crow(int i, int hh) { return (i & 3) + 8 * (i >> 2) + 4 * hh; }
DI float silu_f(float x) { return x * __builtin_amdgcn_rcpf(1.f + __builtin_amdgcn_exp2f(-1.4426950408889634f * x)); }
DI float gelu_f(float x) {
  const float u2 = 2.3022081981443144f * (x + 0.044715f * x * x * x);
  return x * __builtin_amdgcn_rcpf(1.f + __builtin_amdgcn_exp2f(-u2));
}
DI bf16x8 as_frag(u32x4 v) { return __builtin_bit_cast(bf16x8, v); }
DI void load_pair16(const bfu* p0, int hh, u32x2& a, u32x2& b) {
  const u32x4 l = *(const u32x4*)(p0 + 8 * hh);
  const auto s0 = __builtin_amdgcn_permlane32_swap(l[0], l[2], false, false);
  const auto s1 = __builtin_amdgcn_permlane32_swap(l[1], l[3], false, false);
  a[0] = s0[0]; a[1] = s1[0]; b[0] = s0[1]; b[1] = s1[1];
}
DI void store_pair16(bfu* p0, u32x2 a, u32x2 b, int hh) {
  const auto s0 = __builtin_amdgcn_permlane32_swap(a[0], b[0], false, false);
  const auto s1 = __builtin_amdgcn_permlane32_swap(a[1], b[1], false, false);
  u32x4 o = {s0[0], s1[0], s0[1], s1[1]};
  *(u32x4*)(p0 + 8 * hh) = o;
}

constexpr int NB = 4, SEQ = 4096, DM = 1024, NTOK = NB * SEQ;

constexpr size_t OFF_WTIN   = 0;
constexpr size_t OFF_WTOUT0 = OFF_WTIN + 6291456;
constexpr size_t OFF_WTOUT1 = OFF_WTOUT0 + 2097152;
constexpr size_t OFF_WSB    = OFF_WTOUT1 + 2097152;
constexpr size_t OFF_GT     = OFF_WSB + 262144;
constexpr size_t OFF_MODP   = OFF_GT + 65536;
constexpr size_t OFF_KSUM   = OFF_MODP + 1572864;
constexpr size_t OFF_CUM    = OFF_KSUM + 524288;
constexpr size_t OFF_AG     = OFF_CUM + 262144;
constexpr size_t OFF_TOT    = OFF_AG + 262144;
constexpr size_t OFF_HBUF   = OFF_TOT + 4096;
constexpr size_t OFF_PROJ   = OFF_HBUF + 33554432;
constexpr size_t OFF_MIX    = OFF_PROJ + 100663296;
constexpr size_t OFF_VT     = OFF_MIX;
constexpr size_t OFF_QM     = OFF_MIX + 16777216;
constexpr size_t OFF_KM     = OFF_QM + 16777216;
constexpr size_t OFF_VM     = OFF_KM + 16777216;
constexpr size_t OFF_XC     = OFF_VM + 16777216;
constexpr size_t OFF_UST    = OFF_XC + 16777216;
constexpr size_t OFF_END    = OFF_UST + 33816576;
constexpr size_t OFF_KT     = OFF_HBUF;
constexpr size_t OFF_GVT    = OFF_MIX;
constexpr size_t OFF_STATS  = OFF_MIX + 33554432;
constexpr size_t OFF_X1B    = OFF_MIX + 37748736;
constexpr size_t OFF_MODF   = OFF_END;
constexpr size_t OFF_BAR    = OFF_MODF + 98304;
static_assert(OFF_BAR + 16384 <= 268435456ull, "workspace overflow");

struct Params {
  const float *x, *c, *ln_g, *ada_w, *ada_b, *w_in, *w_out, *a_q_g, *a_k_g, *conv_w, *conv_b, *wq, *wk, *wv,
      *w_gates, *b_gates, *out_g, *skip, *c_ln_g, *c_ln_b, *c_ws, *c_bs;
  float* out;
  char* ws;
};

DI void transpose_tile(const float* __restrict__ src, bfu* __restrict__ dst, int K, int N, int k0, int n0, float* st) {
  const int tid = tid_l();
#pragma unroll
  for (int i = 0; i < 4; ++i) {
    const int r = (tid >> 4) + 16 * i, c4 = tid & 15;
    const float4 v = *(const float4*)(src + (size_t)(k0 + r) * N + n0 + 4 * c4);
    float* d = st + r * 65 + 4 * c4;
    d[0] = v.x; d[1] = v.y; d[2] = v.z; d[3] = v.w;
  }
  __syncthreads();
#pragma unroll
  for (int i = 0; i < 2; ++i) {
    const int n = (tid >> 3) + 32 * i, kc = tid & 7;
    float f[8];
#pragma unroll
    for (int j = 0; j < 8; ++j) f[j] = st[(8 * kc + j) * 65 + n];
    u32x4 o = {pack2(f[0], f[1]), pack2(f[2], f[3]), pack2(f[4], f[5]), pack2(f[6], f[7])};
    *(u32x4*)(dst + (size_t)(n0 + n) * K + k0 + 8 * kc) = o;
  }
  __syncthreads();
}

DI void mod_item(const Params& p, int it, float* sm) {
  const int layer = it / 192, rem = it % 192, cgp = rem >> 4, ks = rem & 15;
  const int tid = tid_l();
  {
    const int b = tid >> 6, kk = tid & 63;
    const float cv = p.c[b * 1024 + ks * 64 + kk];
    sm[tid] = silu_f(cv);
  }
  __syncthreads();
  const int col = cgp * 256 + tid;
  const float* w = p.ada_w + (size_t)layer * 1024 * 3072 + (size_t)(ks * 64) * 3072 + col;
  float a0 = 0.f, a1 = 0.f, a2 = 0.f, a3 = 0.f;
#pragma unroll 16
  for (int kk = 0; kk < 64; ++kk) {
    const float wv = w[(size_t)kk * 3072];
    a0 += sm[kk] * wv; a1 += sm[64 + kk] * wv; a2 += sm[128 + kk] * wv; a3 += sm[192 + kk] * wv;
  }
  float* o = (float*)(p.ws + OFF_MODP) + (size_t)((layer * 16 + ks) * 4) * 3072 + col;
  o[0] = a0; o[3072] = a1; o[2 * 3072] = a2; o[3 * 3072] = a3;
  __syncthreads();
}

DI void gt_item(const Params& p, int it) {
  const int ch = it * 256 + tid_l();
  bfu* gt = (bfu*)(p.ws + OFF_GT);
  for (int n = 0; n < 8; ++n) {
    float val = 0.f;
    if (ch < 512) {
      const int g = ch >> 2, ii = ch & 3;
      for (int o = 0; o < 4; ++o) {
        val += p.wq[g * 16 + ii * 4 + o] * p.w_gates[(4 * g + o) * 8 + n];
        val += p.wk[g * 16 + ii * 4 + o] * p.w_gates[(512 + 4 * g + o) * 8 + n];
      }
    } else {
      const int c2 = ch - 512, g = c2 >> 2, ii = c2 & 3;
      for (int o = 0; o < 4; ++o) val += p.wv[g * 16 + ii * 4 + o] * p.w_gates[(1024 + 4 * g + o) * 8 + n];
    }
    gt[n * 1024 + ch] = f2bf(val);
  }
  for (int n = 8; n < 32; ++n) gt[n * 1024 + ch] = 0;
}

DI void wsb_item(const Params& p, int it) {
  const int e = (it * 256 + tid_l()) * 8;
  const int t = (e >> 7) & 127, s0 = e & 127;
  float f[8];
#pragma unroll
  for (int j = 0; j < 8; ++j) f[j] = (s0 + j <= t) ? p.c_ws[e + j] : 0.f;
  u32x4 o = {pack2(f[0], f[1]), pack2(f[2], f[3]), pack2(f[4], f[5]), pack2(f[6], f[7])};
  *(u32x4*)((bfu*)(p.ws + OFF_WSB) + e) = o;
}

DI void norm_item(const Params& p, const float* __restrict__ xin, int layer, int it, float* sm) {
  float* sSc = sm;
  float* sSh = sm + 1024;
  const int tid = tid_l();
  const int row0 = it * 32;
  const int b = row0 >> 12;
  if (layer == 0) {
    const float* modp = (const float*)(p.ws + OFF_MODP);
#pragma unroll
    for (int cc = 0; cc < 4; ++cc) {
      const int col = tid + 256 * cc;
      float sc = p.ada_b[1024 + col], sh = p.ada_b[col];
#pragma unroll
      for (int ks = 0; ks < 16; ++ks) {
        const float* mp = modp + (size_t)(ks * 4 + b) * 3072;
        sc += mp[1024 + col];
        sh += mp[col];
      }
      sSc[col] = p.ln_g[col] * (1.f + sc);
      sSh[col] = sh;
    }
  } else {
    const float* mf = (const float*)(p.ws + OFF_MODF) + (size_t)(4 + b) * 3072;
#pragma unroll
    for (int cc = 0; cc < 4; ++cc) {
      const int col = tid + 256 * cc;
      sSc[col] = p.ln_g[1024 + col] * (1.f + mf[1024 + col]);
      sSh[col] = mf[col];
    }
  }
  __syncthreads();
  const int w = tid >> 6, lane = tid & 63;
  bfu* hb = (bfu*)(p.ws + OFF_HBUF);
#pragma unroll 1
  for (int rb = 0; rb < 2; ++rb) {
    const int rowb = row0 + w * 8 + rb * 4;
    float4 v[4][4];
    if (layer == 0) {
#pragma unroll
      for (int q = 0; q < 4; ++q)
#pragma unroll
        for (int j = 0; j < 4; ++j) v[q][j] = *(const float4*)(xin + (size_t)(rowb + q) * 1024 + lane * 4 + 256 * j);
    } else {
      const bfu* x1b = (const bfu*)(p.ws + OFF_X1B);
#pragma unroll
      for (int q = 0; q < 4; ++q)
#pragma unroll
        for (int j = 0; j < 4; ++j) {
          const u32x2 u = *(const u32x2*)(x1b + (size_t)(rowb + q) * 1024 + lane * 4 + 256 * j);
          v[q][j].x = bflo(u[0]); v[q][j].y = bfhi(u[0]); v[q][j].z = bflo(u[1]); v[q][j].w = bfhi(u[1]);
        }
    }
    float ss[4];
#pragma unroll
    for (int q = 0; q < 4; ++q) {
      float a = 0.f;
#pragma unroll
      for (int j = 0; j < 4; ++j) a += v[q][j].x * v[q][j].x + v[q][j].y * v[q][j].y + v[q][j].z * v[q][j].z + v[q][j].w * v[q][j].w;
      ss[q] = a;
    }
#pragma unroll
    for (int off = 32; off >= 1; off >>= 1)
#pragma unroll
      for (int q = 0; q < 4; ++q) ss[q] += __shfl_xor(ss[q], off);
#pragma unroll
    for (int q = 0; q < 4; ++q) {
      const float rstd = rsqrtf(ss[q] * (1.f / 1024.f) + 1e-6f);
#pragma unroll
      for (int j = 0; j < 4; ++j) {
        const int col = lane * 4 + 256 * j;
        const float4 sc4 = *(const float4*)(sSc + col);
        const float4 sh4 = *(const float4*)(sSh + col);
        const float y0 = v[q][j].x * rstd * sc4.x + sh4.x;
        const float y1 = v[q][j].y * rstd * sc4.y + sh4.y;
        const float y2 = v[q][j].z * rstd * sc4.z + sh4.z;
        const float y3 = v[q][j].w * rstd * sc4.w + sh4.w;
        u32x2 o = {pack2(y0, y1), pack2(y2, y3)};
        *(u32x2*)(hb + (size_t)(rowb + q) * 1024 + col) = o;
      }
    }
  }
  __syncthreads();
}

DI void modfin_item(const Params& p, int it) {
  const int idx = it * 256 + tid_l();
  const int layer = idx / 12288, rem = idx % 12288, b = rem / 3072, col = rem % 3072;
  const float* modp = (const float*)(p.ws + OFF_MODP);
  float a = p.ada_b[layer * 3072 + col];
#pragma unroll
  for (int ks = 0; ks < 16; ++ks) a += modp[(size_t)((layer * 16 + ks) * 4 + b) * 3072 + col];
  ((float*)(p.ws + OFF_MODF))[idx] = a;
}

#define GEMM_GL(KT)                                                                        \
  {                                                                                        \
    _Pragma("unroll") for (int i = 0; i < 8; ++i) ra[i] = *(const u32x4*)(ag + (size_t)i * 32 * K + (KT) * 64); \
    _Pragma("unroll") for (int i = 0; i < 4; ++i) rw[i] = *(const u32x4*)(wg + (size_t)i * 32 * K + (KT) * 64); \
  }
#define GEMM_LS()                                                                          \
  {                                                                                        \
    _Pragma("unroll") for (int i = 0; i < 8; ++i) *(u32x4*)(sA + lds_w + i * 4096) = ra[i]; \
    _Pragma("unroll") for (int i = 0; i < 4; ++i) *(u32x4*)(sW + lds_w + i * 4096) = rw[i]; \
  }
#define GEMM_COMPUTE()                                                                     \
  {                                                                                        \
    _Pragma("unroll") for (int kk = 0; kk < 4; ++kk) {                                     \
      bf16x8 fa[4], fw[2];                                                                 \
      const int sw = (((2 * kk + hh) ^ ((r >> 1) & 7)) << 4);                              \
      _Pragma("unroll") for (int mt = 0; mt < 4; ++mt)                                     \
        fa[mt] = *(const bf16x8*)(sA + (wm * 128 + mt * 32 + r) * 128 + sw);               \
      _Pragma("unroll") for (int nt = 0; nt < 2; ++nt)                                     \
        fw[nt] = *(const bf16x8*)(sW + (wn * 64 + nt * 32 + r) * 128 + sw);                \
      _Pragma("unroll") for (int nt = 0; nt < 2; ++nt)                                     \
        _Pragma("unroll") for (int mt = 0; mt < 4; ++mt)                                   \
          acc[nt][mt] = (EPI == 1) ? MFMA(fa[mt], fw[nt], acc[nt][mt]) : MFMA(fw[nt], fa[mt], acc[nt][mt]); \
    }                                                                                      \
  }

template <int EPI>
DI void gemm_tile(const Params& p, const bfu* __restrict__ A, const bfu* __restrict__ W, int m0, int n0, char* smem,
                  int layer, const float* __restrict__ resid) {
  constexpr int K = 1024;
  const int tid = tid_l(), lane = tid & 63, w = tid >> 6, r = lane & 31, hh = lane >> 5;
  const int wm = w & 1, wn = w >> 1;
  const int lrow = tid >> 3, lc = tid & 7;
  const bfu* ag = A + (size_t)(m0 + lrow) * K + lc * 8;
  const bfu* wg = W + (size_t)(n0 + lrow) * K + lc * 8;
  const int lds_w = lrow * 128 + ((lc ^ ((lrow >> 1) & 7)) << 4);
  char* sA = smem;
  char* sW = smem + 32768;
  u32x4 ra[8], rw[4];
  GEMM_GL(0);
  float gate[2];
  if (EPI == 1) {
    const float* mf = (const float*)(p.ws + OFF_MODF) + (size_t)(layer * 4 + (m0 >> 12)) * 3072 + 2048 + n0 + wn * 64 + r;
    gate[0] = mf[0];
    gate[1] = mf[32];
  }
  f32x16 acc[2][4];
#pragma unroll
  for (int a = 0; a < 2; ++a)
#pragma unroll
    for (int b2 = 0; b2 < 4; ++b2)
#pragma unroll
      for (int i = 0; i < 16; ++i) acc[a][b2][i] = 0.f;
  GEMM_LS();
  __syncthreads();
#pragma unroll 1
  for (int kt = 0; kt < 16; ++kt) {
    const int kn = (kt + 1 < 16) ? kt + 1 : 15;
    GEMM_GL(kn);
    __builtin_amdgcn_sched_barrier(0);
    GEMM_COMPUTE();
    __syncthreads();
    GEMM_LS();
    __syncthreads();
  }

  const int nb = n0 + wn * 64;
  const int b = m0 >> 12;
  const int mw = m0 + wm * 128;
  bfu* proj = (bfu*)(p.ws + OFF_PROJ);
  if (EPI == 1) {
#pragma unroll
    for (int mt = 0; mt < 4; ++mt)
#pragma unroll
      for (int i = 0; i < 16; ++i) {
        const int token = mw + mt * 32 + crow(i, hh);
        const size_t off = (size_t)token * 1024 + nb + r;
        if (layer == 0) {
          const float r0 = resid[off], r1 = resid[off + 32];
          bfu* x1b = (bfu*)(p.ws + OFF_X1B);
          x1b[off] = f2bf(r0 + gate[0] * acc[0][mt][i]);
          x1b[off + 32] = f2bf(r1 + gate[1] * acc[1][mt][i]);
        } else {
          const bfu* x1b = (const bfu*)(p.ws + OFF_X1B);
          const float r0 = bf2f(x1b[off]), r1 = bf2f(x1b[off + 32]);
          p.out[off] = r0 + gate[0] * acc[0][mt][i];
          p.out[off + 32] = r1 + gate[1] * acc[1][mt][i];
        }
      }
  } else if (EPI == 0) {
    if (nb < 1024) {
      const bool isk = nb >= 512;
      const float* gg = isk ? p.a_k_g : p.a_q_g;
      float gv[2][16], cs[2][16];
#pragma unroll
      for (int nt = 0; nt < 2; ++nt)
#pragma unroll
        for (int i = 0; i < 16; ++i) { gv[nt][i] = gg[nt * 32 + crow(i, hh)]; cs[nt][i] = 0.f; }
#pragma unroll
      for (int mt = 0; mt < 4; ++mt) {
        float ss = 0.f;
#pragma unroll
        for (int nt = 0; nt < 2; ++nt)
#pragma unroll
          for (int i = 0; i < 16; ++i) ss += acc[nt][mt][i] * acc[nt][mt][i];
        ss += __shfl_xor(ss, 32);
        const float rstd = rsqrtf(ss * (1.f / 64.f) + 1e-6f);
        const int token = mw + mt * 32 + r;
        bfu* dst = proj + (size_t)token * 3072 + nb;
#pragma unroll
        for (int nt = 0; nt < 2; ++nt) {
          u32x2 ob[4];
#pragma unroll
          for (int g4 = 0; g4 < 4; ++g4) {
            float v[4];
#pragma unroll
            for (int q = 0; q < 4; ++q) {
              v[q] = acc[nt][mt][4 * g4 + q] * rstd * gv[nt][4 * g4 + q];
              cs[nt][4 * g4 + q] += v[q];
            }
            ob[g4][0] = pack2(v[0], v[1]); ob[g4][1] = pack2(v[2], v[3]);
          }
          store_pair16(dst + nt * 32, ob[0], ob[1], hh);
          store_pair16(dst + nt * 32 + 16, ob[2], ob[3], hh);
        }
      }
      if (isk) {
        const int head = (nb - 512) >> 6;
        const int tokblk = (mw & 4095) >> 7;
        float* ks = (float*)(p.ws + OFF_KSUM) + (size_t)((b * 8 + head) * 32 + tokblk) * 64;
#pragma unroll
        for (int nt = 0; nt < 2; ++nt)
#pragma unroll
          for (int i = 0; i < 16; ++i) {
            float v = cs[nt][i];
#pragma unroll
            for (int off = 1; off < 32; off <<= 1) v += __shfl_xor(v, off);
            if (r == 0) ks[nt * 32 + crow(i, hh)] = v;
          }
      }
    } else if (nb < 1536) {
      const int head = (nb - 1024) >> 6;
      bfu* vt = (bfu*)(p.ws + OFF_VT) + (size_t)((b * 8 + head) * 64) * 4096;
#pragma unroll
      for (int nt = 0; nt < 2; ++nt)
#pragma unroll
        for (int mt = 0; mt < 4; ++mt) {
          const int s = (mw & 4095) + mt * 32 + r;
#pragma unroll
          for (int i = 0; i < 16; ++i) vt[(size_t)(nt * 32 + crow(i, hh)) * 4096 + s] = f2bf(acc[nt][mt][i]);
        }
    } else {
      const bool act = (nb < 2048) || (nb >= 2560);
#pragma unroll
      for (int nt = 0; nt < 2; ++nt)
#pragma unroll
        for (int mt = 0; mt < 4; ++mt) {
          const int token = mw + mt * 32 + r;
          bfu* dst = proj + (size_t)token * 3072 + nb + nt * 32;
          u32x2 ob[4];
#pragma unroll
          for (int g4 = 0; g4 < 4; ++g4) {
            float v[4];
#pragma unroll
            for (int q = 0; q < 4; ++q) { v[q] = acc[nt][mt][4 * g4 + q]; if (act) v[q] = silu_f(v[q]); }
            ob[g4][0] = pack2(v[0], v[1]); ob[g4][1] = pack2(v[2], v[3]);
          }
          store_pair16(dst, ob[0], ob[1], hh);
          store_pair16(dst + 16, ob[2], ob[3], hh);
        }
    }
  } else {
    if (nb >= 1024 && nb < 2048) {
      const int c0 = nb - 1024;
      bfu* gvt = (bfu*)(p.ws + OFF_GVT) + (size_t)(b * 1024 + c0) * 4096;
      float* stats = (float*)(p.ws + OFF_STATS);
#pragma unroll
      for (int mt = 0; mt < 4; ++mt) {
        const int token = mw + mt * 32 + r;
        const int s = token & 4095;
        float s1 = 0.f, s2 = 0.f;
#pragma unroll
        for (int nt = 0; nt < 2; ++nt)
#pragma unroll
          for (int i = 0; i < 16; ++i) {
            const float v = gelu_f(acc[nt][mt][i]);
            s1 += v; s2 += v * v;
            gvt[(size_t)(nt * 32 + crow(i, hh)) * 4096 + s] = f2bf(v);
          }
        s1 += __shfl_xor(s1, 32);
        s2 += __shfl_xor(s2, 32);
        if (hh == 0) {
          float2 o; o.x = s1; o.y = s2;
          *(float2*)(stats + ((size_t)token * 16 + (c0 >> 6)) * 2) = o;
        }
      }
    } else {
      const bool isu = nb < 1024;
#pragma unroll
      for (int nt = 0; nt < 2; ++nt)
#pragma unroll
        for (int mt = 0; mt < 4; ++mt) {
          const int token = mw + mt * 32 + r;
          bfu* dst = proj + (size_t)token * 3072 + nb + nt * 32;
          u32x2 ob[4];
#pragma unroll
          for (int g4 = 0; g4 < 4; ++g4) {
            float v[4];
#pragma unroll
            for (int q = 0; q < 4; ++q) { const float a = acc[nt][mt][4 * g4 + q]; v[q] = isu ? gelu_f(a) : silu_f(a); }
            ob[g4][0] = pack2(v[0], v[1]); ob[g4][1] = pack2(v[2], v[3]);
          }
          store_pair16(dst, ob[0], ob[1], hh);
          store_pair16(dst + 16, ob[2], ob[3], hh);
        }
    }
  }
}

DI void mlstm_prep_item(const Params& p, int it, char* smem) {
  const int tid = tid_l(), lane = tid & 63, w = __builtin_amdgcn_readfirstlane(tid >> 6), r = lane & 31, hh = lane >> 5;
  const int b = it >> 6, c = it & 63;
  const int tok0 = b * 4096 + c * 64;
  const bfu* proj = (const bfu*)(p.ws + OFF_PROJ);
  bfu* qm = (bfu*)(p.ws + OFF_QM);
  bfu* km = (bfu*)(p.ws + OFF_KM);
  bfu* vm = (bfu*)(p.ws + OFF_VM);
  bfu* xcb = (bfu*)(p.ws + OFF_XC);
  bfu* ktm = (bfu*)(p.ws + OFF_KT);
  float* sG = (float*)smem;
  float* sWt = (float*)(smem + 8192);
  {
    const int blk = tid & 127, th = tid >> 7;
    const int ch = blk * 4;
    float cw[4][4], cb[4], q_w[4][4], k_w[4][4], v_w[4][4];
#pragma unroll
    for (int j = 0; j < 4; ++j)
#pragma unroll
      for (int i = 0; i < 4; ++i) {
        cw[j][i] = p.conv_w[j * 512 + ch + i];
        q_w[j][i] = p.wq[blk * 16 + j * 4 + i];
        k_w[j][i] = p.wk[blk * 16 + j * 4 + i];
        v_w[j][i] = p.wv[blk * 16 + j * 4 + i];
      }
#pragma unroll
    for (int i = 0; i < 4; ++i) cb[i] = p.conv_b[ch + i];
    float win[4][4];
    const int sl0 = c * 64 + th * 32;
#pragma unroll
    for (int j = 0; j < 3; ++j) {
      const int sp = sl0 - 3 + j;
      if (sp >= 0) {
        const u32x2 v = *(const u32x2*)(proj + (size_t)(b * 4096 + sp) * 3072 + 2048 + ch);
        win[j][0] = bflo(v[0]); win[j][1] = bfhi(v[0]); win[j][2] = bflo(v[1]); win[j][3] = bfhi(v[1]);
      } else {
        win[j][0] = win[j][1] = win[j][2] = win[j][3] = 0.f;
      }
    }
    const float kscale = 0.08838834764831845f;
    const bfu* bxp = proj + ((size_t)b * 4096 + sl0) * 3072 + 2048 + ch;
    u32x2 cur[8], nxt[8];
    float kk8[4][8], vv8[4][8];
#pragma unroll
    for (int q = 0; q < 8; ++q) cur[q] = *(const u32x2*)(bxp + (size_t)q * 3072);
#pragma unroll 1
    for (int t8 = 0; t8 < 4; ++t8) {
      const int tn = (t8 < 3) ? (t8 + 1) * 8 : 24;
#pragma unroll
      for (int q = 0; q < 8; ++q) nxt[q] = *(const u32x2*)(bxp + (size_t)(tn + q) * 3072);
      __builtin_amdgcn_sched_barrier(0);
#pragma unroll
      for (int q = 0; q < 8; ++q) {
        const size_t token = (size_t)b * 4096 + sl0 + t8 * 8 + q;
        const u32x2 v = cur[q];
        win[3][0] = bflo(v[0]); win[3][1] = bfhi(v[0]); win[3][2] = bflo(v[1]); win[3][3] = bfhi(v[1]);
        float xc[4], bq[4], bk[4], bv[4];
#pragma unroll
        for (int i = 0; i < 4; ++i) {
          float a = cb[i];
#pragma unroll
          for (int j = 0; j < 4; ++j) a += cw[j][i] * win[j][i];
          xc[i] = silu_f(a);
        }
#pragma unroll
        for (int o = 0; o < 4; ++o) {
          float aq = 0.f, ak = 0.f, av = 0.f;
#pragma unroll
          for (int i = 0; i < 4; ++i) { aq += xc[i] * q_w[i][o]; ak += xc[i] * k_w[i][o]; av += win[3][i] * v_w[i][o]; }
          bq[o] = aq; bk[o] = ak * kscale; bv[o] = av;
        }
        u32x2 o;
        o[0] = pack2(bq[0], bq[1]); o[1] = pack2(bq[2], bq[3]); *(u32x2*)(qm + token * 512 + ch) = o;
        o[0] = pack2(bk[0], bk[1]); o[1] = pack2(bk[2], bk[3]); *(u32x2*)(km + token * 512 + ch) = o;
#pragma unroll
        for (int o4 = 0; o4 < 4; ++o4) { kk8[o4][q] = bk[o4]; vv8[o4][q] = bv[o4]; }
        o[0] = pack2(xc[0], xc[1]); o[1] = pack2(xc[2], xc[3]); *(u32x2*)(xcb + token * 512 + ch) = o;
#pragma unroll
        for (int j = 0; j < 3; ++j)
#pragma unroll
          for (int i = 0; i < 4; ++i) win[j][i] = win[j + 1][i];
      }
#pragma unroll
      for (int o4 = 0; o4 < 4; ++o4) {
        const size_t off = ((size_t)((b * 4 + (blk >> 5)) * 64 + c) * 128 + (blk & 31) * 4 + o4) * 64 + th * 32 + t8 * 8;
        u32x4 pk = {pack2(kk8[o4][0], kk8[o4][1]), pack2(kk8[o4][2], kk8[o4][3]), pack2(kk8[o4][4], kk8[o4][5]), pack2(kk8[o4][6], kk8[o4][7])};
        *(u32x4*)(ktm + off) = pk;
        u32x4 pv = {pack2(vv8[o4][0], vv8[o4][1]), pack2(vv8[o4][2], vv8[o4][3]), pack2(vv8[o4][4], vv8[o4][5]), pack2(vv8[o4][6], vv8[o4][7])};
        *(u32x4*)(vm + off) = pv;
      }
#pragma unroll
      for (int q = 0; q < 8; ++q) cur[q] = nxt[q];
    }
  }
  __threadfence_block();
  __syncthreads();
  {
    const bfu* gt = (const bfu*)(p.ws + OFF_GT);
    f32x16 acc[2];
#pragma unroll
    for (int tt = 0; tt < 2; ++tt)
#pragma unroll
      for (int i = 0; i < 16; ++i) acc[tt][i] = 0.f;
#pragma unroll 4
    for (int ksi = 0; ksi < 16; ++ksi) {
      const int ch = (16 * w + ksi) * 16 + 8 * hh;
      const bf16x8 af = as_frag(*(const u32x4*)(gt + r * 1024 + ch));
#pragma unroll
      for (int tt = 0; tt < 2; ++tt) {
        const size_t token = (size_t)tok0 + 32 * tt + r;
        const bfu* src = (ch < 512) ? (xcb + token * 512 + ch) : (proj + token * 3072 + 2048 + (ch - 512));
        const bf16x8 bfr = as_frag(*(const u32x4*)src);
        acc[tt] = MFMA(af, bfr, acc[tt]);
      }
    }
#pragma unroll
    for (int tt = 0; tt < 2; ++tt)
#pragma unroll
      for (int i = 0; i < 4; ++i) sG[(w * 8 + 4 * hh + i) * 64 + 32 * tt + r] = acc[tt][i];
  }
  __syncthreads();
  {
    const int head = w, tok = lane;
    float ig = p.b_gates[head], fg = p.b_gates[4 + head];
#pragma unroll
    for (int ww = 0; ww < 4; ++ww) { ig += sG[(ww * 8 + head) * 64 + tok]; fg += sG[(ww * 8 + 4 + head) * 64 + tok]; }
    const float lf = fminf(fg, 0.f) - log1pf(__expf(-fabsf(fg)));
    float cum = lf;
#pragma unroll
    for (int off = 1; off < 64; off <<= 1) {
      const float o = __shfl_up(cum, off);
      if (lane >= off) cum += o;
    }
    const float tot = __shfl(cum, 63);
    const float a = ig - cum;
    const int bh = b * 4 + head;
    ((float*)(p.ws + OFF_CUM))[(size_t)bh * 4096 + c * 64 + tok] = cum;
    ((float*)(p.ws + OFF_AG))[(size_t)bh * 4096 + c * 64 + tok] = a;
    if (lane == 0) ((float*)(p.ws + OFF_TOT))[bh * 64 + c] = tot;
    sWt[head * 64 + tok] = __expf(tot + a);
  }
  __syncthreads();
  {
    const int h = w;
    const int bh = b * 4 + h;
    const bfu* ktc = ktm + (size_t)(bh * 64 + c) * 128 * 64;
    const bfu* vtc = vm + (size_t)(bh * 64 + c) * 128 * 64;
    bfu* ust = (bfu*)(p.ws + OFF_UST) + (size_t)(bh * 64 + c) * 129 * 128;
    float wsr[4][8];
#pragma unroll
    for (int ss = 0; ss < 4; ++ss)
#pragma unroll
      for (int j = 0; j < 8; ++j) wsr[ss][j] = sWt[h * 64 + 16 * ss + 8 * hh + j];
    u32x4 vall[4][4];
#pragma unroll
    for (int vt = 0; vt < 4; ++vt)
#pragma unroll
      for (int ss = 0; ss < 4; ++ss) vall[vt][ss] = *(const u32x4*)(vtc + (size_t)(vt * 32 + r) * 64 + 16 * ss + 8 * hh);
    bf16x8 kall[4][4];
#pragma unroll
    for (int kt = 0; kt < 4; ++kt)
#pragma unroll
      for (int ss = 0; ss < 4; ++ss) kall[kt][ss] = as_frag(*(const u32x4*)(ktc + (size_t)(kt * 32 + r) * 64 + 16 * ss + 8 * hh));
#pragma unroll
    for (int vt = 0; vt < 5; ++vt) {
      bf16x8 vf[4];
#pragma unroll
      for (int ss = 0; ss < 4; ++ss) {
        float f[8];
        if (vt < 4) {
#pragma unroll
          for (int q = 0; q < 4; ++q) { f[2 * q] = bflo(vall[vt < 4 ? vt : 0][ss][q]) * wsr[ss][2 * q]; f[2 * q + 1] = bfhi(vall[vt < 4 ? vt : 0][ss][q]) * wsr[ss][2 * q + 1]; }
        } else {
#pragma unroll
          for (int j = 0; j < 8; ++j) f[j] = (r == 0) ? wsr[ss][j] : 0.f;
        }
        u32x4 pk = {pack2(f[0], f[1]), pack2(f[2], f[3]), pack2(f[4], f[5]), pack2(f[6], f[7])};
        vf[ss] = as_frag(pk);
      }
#pragma unroll
      for (int kp = 0; kp < 2; ++kp) {
        f32x16 acc[2];
#pragma unroll
        for (int kt = 0; kt < 2; ++kt)
#pragma unroll
          for (int i = 0; i < 16; ++i) acc[kt][i] = 0.f;
#pragma unroll
        for (int ss = 0; ss < 4; ++ss)
#pragma unroll
          for (int kt = 0; kt < 2; ++kt) acc[kt] = MFMA(kall[kp * 2 + kt][ss], vf[ss], acc[kt]);
#pragma unroll
        for (int kt = 0; kt < 2; ++kt)
#pragma unroll
          for (int gp = 0; gp < 2; ++gp) {
            u32x2 oa = {pack2(acc[kt][8 * gp], acc[kt][8 * gp + 1]), pack2(acc[kt][8 * gp + 2], acc[kt][8 * gp + 3])};
            u32x2 obb = {pack2(acc[kt][8 * gp + 4], acc[kt][8 * gp + 5]), pack2(acc[kt][8 * gp + 6], acc[kt][8 * gp + 7])};
            const auto s0 = __builtin_amdgcn_permlane32_swap(oa[0], obb[0], false, false);
            const auto s1 = __builtin_amdgcn_permlane32_swap(oa[1], obb[1], false, false);
            u32x4 o = {s0[0], s1[0], s0[1], s1[1]};
            if (vt < 4 || r == 0) *(u32x4*)(ust + (size_t)(vt * 32 + r) * 128 + (kp * 2 + kt) * 32 + 16 * gp + 8 * hh) = o;
          }
      }
    }
  }
  __syncthreads();
}

DI void scan_item(const Params& p, int it) {
  const int id = it * 256 + tid_l();
  const int bh = id / 2064, e8 = id % 2064;
  bfu* base = (bfu*)(p.ws + OFF_UST) + (size_t)bh * 64 * 16512 + e8 * 8;
  const float* tot = (const float*)(p.ws + OFF_TOT) + bh * 64;
  float st[8];
#pragma unroll
  for (int j = 0; j < 8; ++j) st[j] = 0.f;
  for (int c0 = 0; c0 < 64; c0 += 8) {
    u32x4 u[8];
#pragma unroll
    for (int j = 0; j < 8; ++j) u[j] = *(const u32x4*)(base + (size_t)(c0 + j) * 16512);
#pragma unroll
    for (int j = 0; j < 8; ++j) {
      u32x4 o = {pack2(st[0], st[1]), pack2(st[2], st[3]), pack2(st[4], st[5]), pack2(st[6], st[7])};
      *(u32x4*)(base + (size_t)(c0 + j) * 16512) = o;
      const float dec = __expf(tot[c0 + j]);
#pragma unroll
      for (int q = 0; q < 4; ++q) {
        st[2 * q] = dec * st[2 * q] + bflo(u[j][q]);
        st[2 * q + 1] = dec * st[2 * q + 1] + bfhi(u[j][q]);
      }
    }
  }
}

DI void moba_item(const Params& p, int mi, char* smem) {
  const int tid = tid_l(), lane = tid & 63, w = tid >> 6, r = lane & 31, hh = lane >> 5;
  const int jb = 15 - (mi >> 6);
  const int rem = mi & 63;
  const int half = 1 - (rem >> 5);
  const int bh = rem & 31;
  const int b = bh >> 3, h = bh & 7;
  const int q0 = jb * 256 + half * 128;
  const size_t tokbase = (size_t)b * 4096;
  const bfu* proj = (const bfu*)(p.ws + OFF_PROJ);
  const bfu* vtg = (const bfu*)(p.ws + OFF_VT) + (size_t)bh * 64 * 4096;
  float* sKM = (float*)smem;
  char* sK = smem + 4096;
  char* sV = smem + 4096 + 24576;
  {
    const float* ks = (const float*)(p.ws + OFF_KSUM) + (size_t)bh * 32 * 64;
    for (int idx = tid; idx < jb * 64; idx += 256) {
      const int n = idx >> 6, d = idx & 63;
      const float* q2 = ks + (size_t)(2 * n) * 64 + d;
      sKM[idx] = q2[0] + q2[64];
    }
  }
  const int qpos = q0 + w * 32 + r;
  const size_t qtoken = tokbase + qpos;
  u32x4 qf[4];
#pragma unroll
  for (int kk = 0; kk < 4; ++kk) qf[kk] = *(const u32x4*)(proj + qtoken * 3072 + h * 64 + kk * 16 + hh * 8);
  __syncthreads();
  unsigned sel;
  {
    float s1 = -INFINITY, s2 = -INFINITY, s3 = -INFINITY;
    int i1 = -1, i2 = -1, i3 = -1;
    for (int n = 0; n < jb; ++n) {
      float dot = 0.f;
#pragma unroll
      for (int kk = 0; kk < 4; ++kk) {
        const float* km = sKM + n * 64 + kk * 16 + hh * 8;
#pragma unroll
        for (int e = 0; e < 4; ++e) {
          dot += bflo(qf[kk][e]) * km[2 * e];
          dot += bfhi(qf[kk][e]) * km[2 * e + 1];
        }
      }
      dot += __shfl_xor(dot, 32);
      if (dot > s1) { s3 = s2; i3 = i2; s2 = s1; i2 = i1; s1 = dot; i1 = n; }
      else if (dot > s2) { s3 = s2; i3 = i2; s2 = dot; i2 = n; }
      else if (dot > s3) { s3 = dot; i3 = n; }
    }
    if (jb <= 3) sel = (1u << jb) - 1u;
    else sel = (1u << i1) | (1u << i2) | (1u << i3);
  }
  const int ntile = 4 * jb + (half ? 4 : 2);
  const int lrow = tid >> 3, lch = tid & 7;
  u32x4 kregA[2], vregA[2], kregB[2], vregB[2];
  auto gload = [&](int tix, u32x4 (&kreg)[2], u32x4 (&vreg)[2]) {
    const int n = tix >> 2, tk = tix & 3;
    const int key0 = n * 256 + tk * 64;
#pragma unroll
    for (int i = 0; i < 2; ++i) {
      const int row = lrow + 32 * i;
      kreg[i] = *(const u32x4*)(proj + (tokbase + key0 + row) * 3072 + 512 + h * 64 + lch * 8);
      vreg[i] = *(const u32x4*)(vtg + (size_t)row * 4096 + key0 + lch * 8);
    }
  };
  auto lstore = [&](int buf, u32x4 (&kreg)[2], u32x4 (&vreg)[2]) {
#pragma unroll
    for (int i = 0; i < 2; ++i) {
      const int row = lrow + 32 * i;
      const int sw = (row >> 1) & 7;
      *(u32x4*)(sK + buf * 8192 + row * 128 + ((lch ^ sw) << 4)) = kreg[i];
      const int g = lch >> 1, hf = (lch & 1) << 3;
      u32x2 lo = {vreg[i][0], vreg[i][1]}, hi = {vreg[i][2], vreg[i][3]};
      *(u32x2*)(sV + buf * 8192 + row * 128 + (((2 * g) ^ sw) << 4) + hf) = lo;
      *(u32x2*)(sV + buf * 8192 + row * 128 + (((2 * g + 1) ^ sw) << 4) + hf) = hi;
    }
  };
  const f32x16 zero16 = {0.f, 0.f, 0.f, 0.f, 0.f, 0.f, 0.f, 0.f, 0.f, 0.f, 0.f, 0.f, 0.f, 0.f, 0.f, 0.f};
  const int qmax = q0 + w * 32 + 31;
  int lofs[4];
#pragma unroll
  for (int g = 0; g < 4; ++g) lofs[g] = r * 128 + (((2 * g + hh) ^ ((r >> 1) & 7)) << 4);
  auto compute_s = [&](int tix, int buf, f32x16 (&s)[2]) {
    const int key0 = (tix >> 2) * 256 + (tix & 3) * 64;
    if (key0 <= qmax) {
      const char* kb = sK + buf * 8192;
      const bool two = (key0 + 32 <= qmax);
      if ((tix >> 2) == jb) {
        const int lim = qpos - key0 - 4 * hh;
        f32x16 b0, b1;
#pragma unroll
        for (int i = 0; i < 16; ++i) {
          const int cidx = (i & 3) + 8 * (i >> 2);
          b0[i] = (cidx <= lim) ? 0.f : -INFINITY;
          b1[i] = (two && (32 + cidx <= lim)) ? 0.f : -INFINITY;
        }
        s[0] = MFMA(*(const bf16x8*)(kb + lofs[0]), as_frag(qf[0]), b0);
#pragma unroll
        for (int kk = 1; kk < 4; ++kk) s[0] = MFMA(*(const bf16x8*)(kb + lofs[kk]), as_frag(qf[kk]), s[0]);
        if (two) {
          s[1] = MFMA(*(const bf16x8*)(kb + 4096 + lofs[0]), as_frag(qf[0]), b1);
#pragma unroll
          for (int kk = 1; kk < 4; ++kk) s[1] = MFMA(*(const bf16x8*)(kb + 4096 + lofs[kk]), as_frag(qf[kk]), s[1]);
        } else {
          s[1] = b1;
        }
      } else {
        s[0] = MFMA(*(const bf16x8*)(kb + lofs[0]), as_frag(qf[0]), zero16);
#pragma unroll
        for (int kk = 1; kk < 4; ++kk) s[0] = MFMA(*(const bf16x8*)(kb + lofs[kk]), as_frag(qf[kk]), s[0]);
        s[1] = MFMA(*(const bf16x8*)(kb + 4096 + lofs[0]), as_frag(qf[0]), zero16);
#pragma unroll
        for (int kk = 1; kk < 4; ++kk) s[1] = MFMA(*(const bf16x8*)(kb + 4096 + lofs[kk]), as_frag(qf[kk]), s[1]);
      }
    }
  };
  f32x16 oacc[2];
#pragma unroll
  for (int dt = 0; dt < 2; ++dt)
#pragma unroll
    for (int i = 0; i < 16; ++i) oacc[dt][i] = 0.f;
  float mrun = -1e30f;
  f32x16 lacc = zero16;
  const unsigned onev = (r == 0) ? 0x3F803F80u : 0u;
  const u32x4 ones4 = {onev, onev, onev, onev};
  const bf16x8 onesf = as_frag(ones4);
  const float cs = 0.125f * 1.4426950408889634f;
  auto step = [&](int tix, int b0, int b1, int b2, f32x16 (&scur)[2], f32x16 (&snext)[2], u32x4 (&kreg)[2], u32x4 (&vreg)[2]) {
    if (tix + 1 < ntile) compute_s(tix + 1, b1, snext);
    const int n = tix >> 2, tk = tix & 3;
    const int key0 = n * 256 + tk * 64;
    if (key0 <= qmax) {
      const char* vb = sV + b0 * 8192;
      const bool own = (n == jb);
      const bool lsel = own || ((sel >> n) & 1u);
      const bool act1 = (key0 + 32 <= qmax);
      float mt = scur[0][0];
#pragma unroll
      for (int i = 1; i < 16; ++i) mt = fmaxf(mt, scur[0][i]);
#pragma unroll
      for (int i = 0; i < 16; ++i) mt = fmaxf(mt, scur[1][i]);
      mt = fmaxf(mt, __shfl_xor(mt, 32));
      mt = lsel ? mt : -INFINITY;
      const float mnew = fmaxf(mrun, mt);
      const float alpha = __builtin_amdgcn_exp2f((mrun - mnew) * cs);
      mrun = mnew;
      const float nbias = (lsel && mnew > -1e29f) ? -mnew * cs : -INFINITY;
#pragma unroll
      for (int kt = 0; kt < 2; ++kt)
#pragma unroll
        for (int i = 0; i < 16; ++i) scur[kt][i] = __builtin_amdgcn_exp2f(__builtin_fmaf(scur[kt][i], cs, nbias));
      lacc[0] *= alpha;
#pragma unroll
      for (int dt = 0; dt < 2; ++dt)
#pragma unroll
        for (int i = 0; i < 16; ++i) oacc[dt][i] *= alpha;
#pragma unroll
      for (int kt = 0; kt < 2; ++kt) {
        if (kt == 0 || act1) {
#pragma unroll
          for (int ss = 0; ss < 2; ++ss) {
            u32x4 pk = {pack2(scur[kt][8 * ss], scur[kt][8 * ss + 1]), pack2(scur[kt][8 * ss + 2], scur[kt][8 * ss + 3]),
                        pack2(scur[kt][8 * ss + 4], scur[kt][8 * ss + 5]), pack2(scur[kt][8 * ss + 6], scur[kt][8 * ss + 7])};
            const bf16x8 pf = as_frag(pk);
#pragma unroll
            for (int dt = 0; dt < 2; ++dt) {
              const bf16x8 vf = *(const bf16x8*)(vb + dt * 4096 + lofs[2 * kt + ss]);
              oacc[dt] = MFMA(vf, pf, oacc[dt]);
            }
            lacc = MFMA(onesf, pf, lacc);
          }
        }
      }
    }
    lstore(b2, kreg, vreg);
    gload((tix + 4 < ntile) ? tix + 4 : ntile - 1, kreg, vreg);
    __syncthreads();
  };
  gload(0, kregA, vregA);
  gload(1, kregB, vregB);
  lstore(0, kregA, vregA);
  gload((2 < ntile) ? 2 : ntile - 1, kregA, vregA);
  lstore(1, kregB, vregB);
  gload((3 < ntile) ? 3 : ntile - 1, kregB, vregB);
  __syncthreads();
  f32x16 sa[2], sb[2];
  sa[0] = zero16; sa[1] = zero16; sb[0] = zero16; sb[1] = zero16;
  compute_s(0, 0, sa);
  {
    int b0 = 0;
#pragma unroll 1
    for (int tix = 0; tix < ntile; tix += 2) {
      const int b1 = (b0 == 2) ? 0 : b0 + 1;
      const int b2 = (b1 == 2) ? 0 : b1 + 1;
      step(tix, b0, b1, b2, sa, sb, kregA, vregA);
      if (tix + 1 < ntile) step(tix + 1, b1, b2, b0, sb, sa, kregB, vregB);
      b0 = b2;
    }
  }
  {
    const float ltot = __shfl(lacc[0], r);
    const float inv = 1.f / ltot;
    bfu* ym = (bfu*)(p.ws + OFF_HBUF);
#pragma unroll
    for (int dt = 0; dt < 2; ++dt) {
      u32x2 ob[4], azp[4];
      load_pair16(proj + qtoken * 3072 + 1536 + h * 64 + dt * 32, hh, azp[0], azp[1]);
      load_pair16(proj + qtoken * 3072 + 1536 + h * 64 + dt * 32 + 16, hh, azp[2], azp[3]);
#pragma unroll
      for (int g4 = 0; g4 < 4; ++g4) {
        const u32x2 az = azp[g4];
        const float y0 = oacc[dt][4 * g4] * inv * bflo(az[0]);
        const float y1 = oacc[dt][4 * g4 + 1] * inv * bfhi(az[0]);
        const float y2 = oacc[dt][4 * g4 + 2] * inv * bflo(az[1]);
        const float y3 = oacc[dt][4 * g4 + 3] * inv * bfhi(az[1]);
        ob[g4][0] = pack2(y0, y1); ob[g4][1] = pack2(y2, y3);
      }
      store_pair16(ym + qtoken * 1024 + h * 64 + dt * 32, ob[0], ob[1], hh);
      store_pair16(ym + qtoken * 1024 + h * 64 + dt * 32 + 16, ob[2], ob[3], hh);
    }
  }
}

DI void mlstm_out_item(const Params& p, int it) {
  const int lane = tid_l() & 63, r = lane & 31, hh = lane >> 5;
  const int bh = it >> 7, c = (it >> 1) & 63, tt = it & 1;
  const int b = bh >> 2, h = bh & 3;
  const size_t tok0 = (size_t)b * 4096 + c * 64;
  const bfu* proj = (const bfu*)(p.ws + OFF_PROJ);
  const bfu* qm = (const bfu*)(p.ws + OFF_QM);
  const bfu* km = (const bfu*)(p.ws + OFF_KM);
  const bfu* vm = (const bfu*)(p.ws + OFF_VM);
  const bfu* xcb = (const bfu*)(p.ws + OFF_XC);
  const bfu* cst = (const bfu*)(p.ws + OFF_UST) + (size_t)(bh * 64 + c) * 129 * 128;
  const float* cumv = (const float*)(p.ws + OFF_CUM) + (size_t)bh * 4096 + c * 64;
  const float* agv = (const float*)(p.ws + OFF_AG) + (size_t)bh * 4096 + c * 64;
  bfu* ym = (bfu*)(p.ws + OFF_HBUF);
  {
    const size_t token = tok0 + 32 * tt + r;
    u32x4 qf[8];
#pragma unroll
    for (int kk = 0; kk < 8; ++kk) qf[kk] = *(const u32x4*)(qm + token * 512 + h * 128 + 16 * kk + 8 * hh);
    const float cum_t = cumv[32 * tt + r];
    const float e_t = __expf(cum_t);
    float dn;
    {
      f32x16 an;
#pragma unroll
      for (int i = 0; i < 16; ++i) an[i] = 0.f;
#pragma unroll
      for (int kk = 0; kk < 8; ++kk) {
        u32x4 cv = {0u, 0u, 0u, 0u};
        if (r == 0) cv = *(const u32x4*)(cst + (size_t)128 * 128 + 16 * kk + 8 * hh);
        an = MFMA(as_frag(cv), as_frag(qf[kk]), an);
      }
      dn = __shfl(an[0], r);
    }
    f32x16 ai[4];
#pragma unroll
    for (int vt = 0; vt < 4; ++vt) {
#pragma unroll
      for (int i = 0; i < 16; ++i) ai[vt][i] = 0.f;
#pragma unroll
      for (int kk = 0; kk < 8; ++kk) {
        const u32x4 cv = *(const u32x4*)(cst + (size_t)(vt * 32 + r) * 128 + 16 * kk + 8 * hh);
        ai[vt] = MFMA(as_frag(cv), as_frag(qf[kk]), ai[vt]);
      }
#pragma unroll
      for (int i = 0; i < 16; ++i) ai[vt][i] *= e_t;
    }
    float den_i = 0.f;
#pragma unroll 1
    for (int st = 0; st <= tt; ++st) {
      f32x16 sacc;
#pragma unroll
      for (int i = 0; i < 16; ++i) sacc[i] = 0.f;
#pragma unroll
      for (int kk = 0; kk < 8; ++kk) {
        const bf16x8 kf = as_frag(*(const u32x4*)(km + (tok0 + 32 * st + r) * 512 + h * 128 + 16 * kk + 8 * hh));
        sacc = MFMA(kf, as_frag(qf[kk]), sacc);
      }
      const int tl = 32 * tt + r;
#pragma unroll
      for (int g4 = 0; g4 < 4; ++g4) {
        const float4 av = *(const float4*)(agv + 32 * st + 8 * g4 + 4 * hh);
        const float aa[4] = {av.x, av.y, av.z, av.w};
#pragma unroll
        for (int q = 0; q < 4; ++q) {
          const int s = 32 * st + 8 * g4 + 4 * hh + q;
          const float wgt = (s <= tl) ? sacc[4 * g4 + q] * __expf(cum_t + aa[q]) : 0.f;
          sacc[4 * g4 + q] = wgt;
          den_i += wgt;
        }
      }
#pragma unroll
      for (int ss = 0; ss < 2; ++ss) {
        u32x4 pk = {pack2(sacc[8 * ss], sacc[8 * ss + 1]), pack2(sacc[8 * ss + 2], sacc[8 * ss + 3]),
                    pack2(sacc[8 * ss + 4], sacc[8 * ss + 5]), pack2(sacc[8 * ss + 6], sacc[8 * ss + 7])};
        const bf16x8 pf = as_frag(pk);
#pragma unroll
        for (int vt = 0; vt < 4; ++vt) {
          const bfu* vp = vm + ((size_t)(bh * 64 + c) * 128 + vt * 32 + r) * 64 + 32 * st + 16 * ss + 4 * hh;
          const u32x2 lo = *(const u32x2*)vp;
          const u32x2 hi = *(const u32x2*)(vp + 8);
          u32x4 vv = {lo[0], lo[1], hi[0], hi[1]};
          ai[vt] = MFMA(as_frag(vv), pf, ai[vt]);
        }
      }
    }
    den_i += __shfl_xor(den_i, 32);
    const float den = den_i + e_t * dn;
    const float inv = 1.f / fmaxf(fabsf(den), 1.f);
    float s1 = 0.f;
#pragma unroll
    for (int vt = 0; vt < 4; ++vt)
#pragma unroll
      for (int i = 0; i < 16; ++i) {
        const float hv = ai[vt][i] * inv;
        ai[vt][i] = hv;
        s1 += hv;
      }
    s1 += __shfl_xor(s1, 32);
    const float mean = s1 * (1.f / 128.f);
    float s2 = 0.f;
#pragma unroll
    for (int vt = 0; vt < 4; ++vt)
#pragma unroll
      for (int i = 0; i < 16; ++i) { const float d = ai[vt][i] - mean; s2 += d * d; }
    s2 += __shfl_xor(s2, 32);
    const float rstd = rsqrtf(s2 * (1.f / 128.f) + 1e-5f);
#pragma unroll
    for (int vt = 0; vt < 4; ++vt) {
      u32x2 ob[4], xvp[4], zvp[4];
#pragma unroll
      for (int gp = 0; gp < 2; ++gp) {
        load_pair16(xcb + token * 512 + h * 128 + 32 * vt + 16 * gp, hh, xvp[2 * gp], xvp[2 * gp + 1]);
        load_pair16(proj + token * 3072 + 2560 + h * 128 + 32 * vt + 16 * gp, hh, zvp[2 * gp], zvp[2 * gp + 1]);
      }
#pragma unroll
      for (int g4 = 0; g4 < 4; ++g4) {
        const int v = 32 * vt + 8 * g4 + 4 * hh;
        const float4 og = *(const float4*)(p.out_g + h * 128 + v);
        const float4 sk = *(const float4*)(p.skip + h * 128 + v);
        const u32x2 xv = xvp[g4];
        const u32x2 zv = zvp[g4];
        const float y0 = ((ai[vt][4 * g4] - mean) * rstd * og.x + sk.x * bflo(xv[0])) * bflo(zv[0]);
        const float y1 = ((ai[vt][4 * g4 + 1] - mean) * rstd * og.y + sk.y * bfhi(xv[0])) * bfhi(zv[0]);
        const float y2 = ((ai[vt][4 * g4 + 2] - mean) * rstd * og.z + sk.z * bflo(xv[1])) * bflo(zv[1]);
        const float y3 = ((ai[vt][4 * g4 + 3] - mean) * rstd * og.w + sk.w * bfhi(xv[1])) * bfhi(zv[1]);
        ob[g4][0] = pack2(y0, y1); ob[g4][1] = pack2(y2, y3);
      }
      store_pair16(ym + token * 1024 + 512 + h * 128 + 32 * vt, ob[0], ob[1], hh);
      store_pair16(ym + token * 1024 + 512 + h * 128 + 32 * vt + 16, ob[2], ob[3], hh);
    }
  }
}

DI void sgu_item(const Params& p, int it, char* smem) {
  const int tid = tid_l(), lane = tid & 63, w = tid >> 6, r = lane & 31, hh = lane >> 5;
  const int g = it & 7, n = (it >> 3) & 31, b = it >> 8;
  const size_t tok0 = (size_t)b * 4096 + n * 128;
  float* sMu = (float*)smem;
  float* sRs = sMu + 128;
  if (tid < 128) {
    const float* st = (const float*)(p.ws + OFF_STATS) + (tok0 + tid) * 32;
    float s1 = 0.f, s2 = 0.f;
#pragma unroll
    for (int q = 0; q < 16; ++q) { s1 += st[2 * q]; s2 += st[2 * q + 1]; }
    const float mean = s1 * (1.f / 1024.f);
    const float var = fmaxf(s2 * (1.f / 1024.f) - mean * mean, 0.f);
    sMu[tid] = mean;
    sRs[tid] = rsqrtf(var + 1e-5f);
  }
  __syncthreads();
  const int cch = g * 128 + w * 32 + r;
  const float lng = p.c_ln_g[cch], lnb = p.c_ln_b[cch];
  const bfu* gvt = (const bfu*)(p.ws + OFF_GVT) + ((size_t)b * 1024 + cch) * 4096 + n * 128;
  const bfu* wsb = (const bfu*)(p.ws + OFF_WSB) + (size_t)g * 128 * 128;
  const bfu* proj = (const bfu*)(p.ws + OFF_PROJ);
  f32x16 acc[4];
#pragma unroll
  for (int tt = 0; tt < 4; ++tt)
#pragma unroll
    for (int i = 0; i < 16; ++i) acc[tt][i] = 0.f;
#pragma unroll
  for (int ks = 0; ks < 8; ++ks) {
    const u32x4 raw = *(const u32x4*)(gvt + 16 * ks + 8 * hh);
    float f[8];
#pragma unroll
    for (int q = 0; q < 4; ++q) { f[2 * q] = bflo(raw[q]); f[2 * q + 1] = bfhi(raw[q]); }
#pragma unroll
    for (int j = 0; j < 8; ++j) {
      const int s = 16 * ks + 8 * hh + j;
      f[j] = (f[j] - sMu[s]) * sRs[s] * lng + lnb;
    }
    u32x4 pk = {pack2(f[0], f[1]), pack2(f[2], f[3]), pack2(f[4], f[5]), pack2(f[6], f[7])};
    const bf16x8 af = as_frag(pk);
#pragma unroll
    for (int tt = 0; tt < 4; ++tt) {
      if (32 * tt + 31 >= 16 * ks) {
        const bf16x8 bfr = as_frag(*(const u32x4*)(wsb + (size_t)(32 * tt + r) * 128 + 16 * ks + 8 * hh));
        acc[tt] = MFMA(af, bfr, acc[tt]);
      }
    }
  }
  bfu* ym = (bfu*)(p.ws + OFF_HBUF);
#pragma unroll
  for (int tt = 0; tt < 4; ++tt) {
    const int t = 32 * tt + r;
    const size_t token = tok0 + t;
    const float bsv = p.c_bs[g * 128 + t];
    u32x2 ob[4], uvp[4], zvp[4];
#pragma unroll
    for (int gp = 0; gp < 2; ++gp) {
      load_pair16(proj + token * 3072 + g * 128 + w * 32 + 16 * gp, hh, uvp[2 * gp], uvp[2 * gp + 1]);
      load_pair16(proj + token * 3072 + 2048 + g * 128 + w * 32 + 16 * gp, hh, zvp[2 * gp], zvp[2 * gp + 1]);
    }
#pragma unroll
    for (int g4 = 0; g4 < 4; ++g4) {
      const u32x2 uv = uvp[g4];
      const u32x2 zv = zvp[g4];
      const float y0 = bflo(uv[0]) * (acc[tt][4 * g4] + bsv) * bflo(zv[0]);
      const float y1 = bfhi(uv[0]) * (acc[tt][4 * g4 + 1] + bsv) * bfhi(zv[0]);
      const float y2 = bflo(uv[1]) * (acc[tt][4 * g4 + 2] + bsv) * bflo(zv[1]);
      const float y3 = bfhi(uv[1]) * (acc[tt][4 * g4 + 3] + bsv) * bfhi(zv[1]);
      ob[g4][0] = pack2(y0, y1); ob[g4][1] = pack2(y2, y3);
    }
    store_pair16(ym + token * 1024 + g * 128 + w * 32, ob[0], ob[1], hh);
    store_pair16(ym + token * 1024 + g * 128 + w * 32 + 16, ob[2], ob[3], hh);
  }
  __syncthreads();
}

#ifndef ONLY_PH
#define ONLY_PH -1
#endif
#define PH_ON(x) (ONLY_PH < 0 || ONLY_PH == (x))
template <int ph>
DI void run_phase(const Params& pin, char* smem, bool rep) {
  const int G = gridDim.x, bid = blockIdx.x;
  if (!PH_ON(ph)) return;
  const Params& p = pin;
  switch (ph) {
    case 0: if (PH_ON(0)) {
      for (int it = bid; it < 1156; it += G) {
        if (it < 384) mod_item(p, it, (float*)smem);
        else if (it < 1152) { const int t = it - 384; transpose_tile(p.w_in, (bfu*)(p.ws + OFF_WTIN), 1024, 3072, (t & 15) * 64, (t >> 4) * 64, (float*)smem); }
        else gt_item(p, it - 1152);
      }
    } break;
    case 1: if (PH_ON(1))
      for (int it = bid; it < 512 + 96; it += G) { if (it < 512) norm_item(p, p.x, 0, it, (float*)smem); else modfin_item(p, it - 512); }
      break;
    case 2: if (PH_ON(2))
      if ((G & 7) == 0) {
        const int x = bid & 7;
        for (int lt = bid >> 3; lt < 192; lt += G >> 3)
          gemm_tile<0>(p, (const bfu*)(p.ws + OFF_HBUF), (const bfu*)(p.ws + OFF_WTIN), (x * 8 + lt / 24) * 256, (lt % 24) * 128, smem, 0, nullptr);
      } else {
        for (int t = bid; t < 64 * 24; t += G)
          gemm_tile<0>(p, (const bfu*)(p.ws + OFF_HBUF), (const bfu*)(p.ws + OFF_WTIN), (t / 24) * 256, (t % 24) * 128, smem, 0, nullptr);
      }
      break;
    case 3: if (PH_ON(3)) {
      const bool split = (G >= 512);
      for (int it = bid; it < 1600; it += (split ? (bid < 256 ? 1600 : G - 256) : G)) {
        if (it < 256) mlstm_prep_item(p, it, smem);
        else if (it < 1024) { const int t = it - 256; transpose_tile(p.w_in + (size_t)1024 * 3072, (bfu*)(p.ws + OFF_WTIN), 1024, 3072, (t & 15) * 64, (t >> 4) * 64, (float*)smem); }
        else if (it < 1280) { const int t = it - 1024; transpose_tile(p.w_out, (bfu*)(p.ws + OFF_WTOUT0), 1024, 1024, (t & 15) * 64, (t >> 4) * 64, (float*)smem); }
        else if (it < 1536) { const int t = it - 1280; transpose_tile(p.w_out + 1024 * 1024, (bfu*)(p.ws + OFF_WTOUT1), 1024, 1024, (t & 15) * 64, (t >> 4) * 64, (float*)smem); }
        else wsb_item(p, it - 1536);
      }
    } break;
    case 4: if (PH_ON(4)) {
      for (int it = bid; it < 129; it += G) { if (!rep) scan_item(p, it); }
      if ((G & 7) == 0) {
        const int x = bid & 7, nl = G >> 3, local = bid >> 3;
        for (int rd = 0; rd * nl < 128; ++rd) {
          const int li = (rd & 1) ? (rd + 1) * nl - 1 - local : rd * nl + local;
          if (li >= 128 || li < 0) continue;
          const int jj = li >> 3, rem = li & 7;
          moba_item(p, (jj << 6) | ((rem >> 2) << 5) | (x * 4 + (rem & 3)), smem);
        }
      } else {
        for (int rd = 0; rd * G < 1024; ++rd) {
          const int pos = (rd & 1) ? (rd + 1) * G - 1 - bid : rd * G + bid;
          if (pos >= 1024) continue;
          moba_item(p, pos, smem);
        }
      }
    } break;
    case 5: if (PH_ON(5)) {
      const int gw = __builtin_amdgcn_readfirstlane(bid * 4 + (tid_l() >> 6));
      for (int it = gw; it < 2048; it += G * 4) mlstm_out_item(p, it);
    } break;
    case 6: if (PH_ON(6))
      if ((G & 7) == 0) {
        const int x = bid & 7;
        for (int lt = bid >> 3; lt < 64; lt += G >> 3)
          gemm_tile<1>(p, (const bfu*)(p.ws + OFF_HBUF), (const bfu*)(p.ws + OFF_WTOUT0), (x * 8 + lt / 8) * 256, (lt % 8) * 128, smem, 0, p.x);
      } else {
        for (int t = bid; t < 64 * 8; t += G)
          gemm_tile<1>(p, (const bfu*)(p.ws + OFF_HBUF), (const bfu*)(p.ws + OFF_WTOUT0), (t / 8) * 256, (t % 8) * 128, smem, 0, p.x);
      }
      break;
    case 7: if (PH_ON(7))
      for (int it = bid; it < 512; it += G) norm_item(p, p.out, 1, it, (float*)smem);
      break;
    case 8: if (PH_ON(8))
      if ((G & 7) == 0) {
        const int x = bid & 7;
        for (int lt = bid >> 3; lt < 192; lt += G >> 3)
          gemm_tile<2>(p, (const bfu*)(p.ws + OFF_HBUF), (const bfu*)(p.ws + OFF_WTIN), (x * 8 + lt / 24) * 256, (lt % 24) * 128, smem, 1, nullptr);
      } else {
        for (int t = bid; t < 64 * 24; t += G)
          gemm_tile<2>(p, (const bfu*)(p.ws + OFF_HBUF), (const bfu*)(p.ws + OFF_WTIN), (t / 24) * 256, (t % 24) * 128, smem, 1, nullptr);
      }
      break;
    case 9: if (PH_ON(9))
      for (int it = bid; it < 1024; it += G) sgu_item(p, it, smem);
      break;
    case 10: if (PH_ON(10))
      if ((G & 7) == 0) {
        const int x = bid & 7;
        for (int lt = bid >> 3; lt < 64; lt += G >> 3)
          gemm_tile<1>(p, (const bfu*)(p.ws + OFF_HBUF), (const bfu*)(p.ws + OFF_WTOUT1), (x * 8 + lt / 8) * 256, (lt % 8) * 128, smem, 1, p.out);
      } else {
        for (int t = bid; t < 64 * 8; t += G)
          gemm_tile<1>(p, (const bfu*)(p.ws + OFF_HBUF), (const bfu*)(p.ws + OFF_WTOUT1), (t / 8) * 256, (t % 8) * 128, smem, 1, p.out);
      }
      break;
    default: break;
  }
}


#define XB_TMO      128
#define XB_XCNT(j)  (256  + 64 * (j))
#define XB_XSUB(j)  (1280 + 64 * (j))
#define XB_XGEN(j)  (2304 + 64 * (j))
#define XB_TOP      3328
#define XB_TOPGEN   3392
#define XCD_BAR_WORDS 3456
#define XB_SPIN_CAP (1u << 18)
#define LAS __attribute__((address_space(3)))

__device__ __forceinline__ unsigned xb_ld(unsigned* p)              { return __hip_atomic_load(p, __ATOMIC_RELAXED, __HIP_MEMORY_SCOPE_AGENT); }
__device__ __forceinline__ unsigned xb_add(unsigned* p, unsigned v) { return __hip_atomic_fetch_add(p, v, __ATOMIC_RELAXED, __HIP_MEMORY_SCOPE_AGENT); }
__device__ __forceinline__ unsigned xb_xcc_id() { return (unsigned)__builtin_amdgcn_s_getreg((3 << 11) | 20) & 0xFu; }
#define XB_SPIN(cond, bar) do { unsigned _sp = 0; while (cond) { __builtin_amdgcn_s_sleep(1); \
    if ((++_sp & 255u) == 0u) { if (xb_ld(&(bar)[XB_TMO])) break; if (_sp > XB_SPIN_CAP) { atomicAdd(&(bar)[XB_TMO], 1u); break; } } } } while (0)

struct XcdBarrier {
    unsigned* bar; unsigned x;
    volatile LAS unsigned* st;
};

__device__ __forceinline__ XcdBarrier xcd_barrier_post(unsigned* bar, volatile LAS unsigned* st) {
    XcdBarrier b; b.bar = bar; b.x = xb_xcc_id(); b.st = st;
    if (threadIdx.x == 0) (void)xb_add(&bar[XB_XCNT(b.x)], 1u);
    return b;
}
__device__ __forceinline__ void xcd_barrier_complete(unsigned* bar, unsigned x, unsigned& nloc, unsigned& nx) {
    const unsigned G = gridDim.x * gridDim.y * gridDim.z;
    unsigned sum, cnt, mine, sp = 0u;
    for (;;) {
        sum = 0u; cnt = 0u; mine = 0u;
#pragma unroll
        for (unsigned j = 0; j < 16; ++j) { const unsigned c = xb_ld(&bar[XB_XCNT(j)]); sum += c; cnt += (c > 0u) ? 1u : 0u; mine = (j == x) ? c : mine; }
        if (sum == G) break;
        __builtin_amdgcn_s_sleep(1);
        if ((++sp & 255u) == 0u) { if (xb_ld(&bar[XB_TMO])) break; if (sp > XB_SPIN_CAP) { atomicAdd(&bar[XB_TMO], 1u); break; } }
    }
    nloc = mine > 0u ? mine : 1u; nx = cnt > 0u ? cnt : 1u;
}

__device__ __forceinline__ void xcd_barrier(const XcdBarrier& b) {
    asm volatile("s_waitcnt vmcnt(0)" ::: "memory");
    __syncthreads();
    if (threadIdx.x == 0) {
        unsigned* bar = b.bar;
        __builtin_amdgcn_s_waitcnt(0);
        unsigned nloc = b.st[0], nx = b.st[1];
        if (nloc == 0u) { xcd_barrier_complete(bar, b.x, nloc, nx); b.st[0] = nloc; b.st[1] = nx; }
        const unsigned old = xb_add(&bar[XB_XSUB(b.x)], 1u);
        const unsigned gen = old / nloc;
        if (old + 1u == (gen + 1u) * nloc) {
            __builtin_amdgcn_fence(__ATOMIC_RELEASE, "agent");
            asm volatile("s_waitcnt vmcnt(0)" ::: "memory");
            const unsigned og = xb_add(&bar[XB_TOP], 1u);
            const unsigned tg = og / nx;
            if (og + 1u == (tg + 1u) * nx) xb_add(&bar[XB_TOPGEN], 1u);
            else XB_SPIN(xb_ld(&bar[XB_TOPGEN]) == tg, bar);
            __builtin_amdgcn_fence(__ATOMIC_ACQUIRE, "agent");
            xb_add(&bar[XB_XGEN(b.x)], 1u);
            asm volatile("s_waitcnt vmcnt(0)" ::: "memory");
        } else {
            XB_SPIN(xb_ld(&bar[XB_XGEN(b.x)]) == gen, bar);
            __builtin_amdgcn_fence(__ATOMIC_ACQUIRE, "agent");
            asm volatile("s_waitcnt vmcnt(0)" ::: "memory");
        }
    }
    __syncthreads();
}


constexpr int NPHASE = 11;

__global__ void __launch_bounds__(256, 2) fwd_mega(Params p, int never) {
  __shared__ __attribute__((aligned(16))) char smem[65536];
  cg::grid_group grid = cg::this_grid();
  if (never < 0) grid.sync();
  __shared__ uint4 xb_words;
  if (threadIdx.x == 0) xb_words = make_uint4(0u, 0u, 0u, 0u);
  __syncthreads();
  XcdBarrier xb = xcd_barrier_post((unsigned*)(p.ws + OFF_BAR), (volatile LAS unsigned*)&xb_words);
#ifndef REP_PH
#define REP_PH -1
#endif
#define PHASE(n)                                                      \
  run_phase<n>(p, smem, false);                                       \
  if (REP_PH == n) { xcd_barrier(xb); run_phase<n>(p, smem, true); }  \
  if (n + 1 < NPHASE) xcd_barrier(xb);
  PHASE(0) PHASE(1) PHASE(2) PHASE(3) PHASE(4) PHASE(5) PHASE(6) PHASE(7) PHASE(8) PHASE(9) PHASE(10)
}

extern "C" void kernel_launch(void* const* d_in, const int* in_sizes, int n_in, void* d_out, int out_size, void* d_ws,
                              size_t ws_size, hipStream_t stream) {
  Params p{};
  p.x = (const float*)d_in[0]; p.c = (const float*)d_in[1]; p.ln_g = (const float*)d_in[2];
  p.ada_w = (const float*)d_in[3]; p.ada_b = (const float*)d_in[4]; p.w_in = (const float*)d_in[5];
  p.w_out = (const float*)d_in[6]; p.a_q_g = (const float*)d_in[7]; p.a_k_g = (const float*)d_in[8];
  p.conv_w = (const float*)d_in[9]; p.conv_b = (const float*)d_in[10]; p.wq = (const float*)d_in[11];
  p.wk = (const float*)d_in[12]; p.wv = (const float*)d_in[13]; p.w_gates = (const float*)d_in[14];
  p.b_gates = (const float*)d_in[15]; p.out_g = (const float*)d_in[16]; p.skip = (const float*)d_in[17];
  p.c_ln_g = (const float*)d_in[18]; p.c_ln_b = (const float*)d_in[19]; p.c_ws = (const float*)d_in[20];
  p.c_bs = (const float*)d_in[21];
  p.out = (float*)d_out;
  p.ws = (char*)d_ws;
  static int grid_blocks = 0;
  if (!grid_blocks) {
    int dev = 0, cus = 0, per_cu = 0;
    hipGetDevice(&dev);
    hipDeviceGetAttribute(&cus, hipDeviceAttributeMultiprocessorCount, dev);
    hipOccupancyMaxActiveBlocksPerMultiprocessor(&per_cu, fwd_mega, 256, 0);
    if (per_cu > 2) per_cu = 2;
    if (per_cu < 1) per_cu = 1;
    grid_blocks = cus * per_cu;
  }
  hipMemsetAsync((char*)d_ws + OFF_BAR, 0, XCD_BAR_WORDS * 4, stream);
  int never = 0;
  void* args[] = {&p, &never};
  hipError_t e = hipLaunchCooperativeKernel((void*)fwd_mega, dim3(grid_blocks), dim3(256), args, 0, stream);
  if (e != hipSuccess) fprintf(stderr, "cooperative launch failed: %s (grid %d)\n", hipGetErrorString(e), grid_blocks);
}
```

```cpp
#include <hip/hip_runtime.h>
#include <hip/hip_cooperative_groups.h>
#include <stdint.h>
#include <cstdio>
#include <type_traits>
namespace cg = cooperative_groups;
#define DI __device__ __forceinline__

#ifndef MK_FUSED
#define MK_FUSED 1
#endif

typedef unsigned short bfu;
typedef short bf16x8 __attribute__((ext_vector_type(8)));
typedef float f32x16 __attribute__((ext_vector_type(16)));
typedef float f32x2 __attribute__((ext_vector_type(2)));
typedef __bf16 bf16x2v __attribute__((ext_vector_type(2)));
typedef unsigned u32x4 __attribute__((ext_vector_type(4)));
typedef unsigned u32x2 __attribute__((ext_vector_type(2)));

#define MFMA(a, b, c) __builtin_amdgcn_mfma_f32_32x32x16_bf16((a), (b), (c), 0, 0, 0)

DI unsigned pack2(float a, float b) { f32x2 v = {a, b}; bf16x2v r = __builtin_convertvector(v, bf16x2v); return __builtin_bit_cast(unsigned, r); }
DI float bflo(unsigned u) { return __uint_as_float(u << 16); }
DI float bfhi(unsigned u) { return __uint_as_float(u & 0xffff0000u); }
DI bfu f2bf(float a) { return (bfu)(pack2(a, 0.f) & 0xffffu); }
DI float bf2f(bfu h) { return __uint_as_float(((unsigned)h) << 16); }
DI int tid_l() { int t = threadIdx.x; asm volatile("" : "+v"(t)); return t; }
DI int crow(int i, int hh) { return (i & 3) + 8 * (i >> 2) + 4 * hh; }
DI float silu_f(float x) { return x * __builtin_amdgcn_rcpf(1.f + __builtin_amdgcn_exp2f(-1.4426950408889634f * x)); }
DI float gelu_f(float x) {
  const float u2 = 2.3022081981443144f * (x + 0.044715f * x * x * x);
  return x * __builtin_amdgcn_rcpf(1.f + __builtin_amdgcn_exp2f(-u2));
}
DI bf16x8 as_frag(u32x4 v) { return __builtin_bit_cast(bf16x8, v); }
DI void load_pair16(const bfu* p0, int hh, u32x2& a, u32x2& b) {
  const u32x4 l = *(const u32x4*)(p0 + 8 * hh);
  const auto s0 = __builtin_amdgcn_permlane32_swap(l[0], l[2], false, false);
  const auto s1 = __builtin_amdgcn_permlane32_swap(l[1], l[3], false, false);
  a[0] = s0[0]; a[1] = s1[0]; b[0] = s0[1]; b[1] = s1[1];
}
DI void store_pair16(bfu* p0, u32x2 a, u32x2 b, int hh) {
  const auto s0 = __builtin_amdgcn_permlane32_swap(a[0], b[0], false, false);
  const auto s1 = __builtin_amdgcn_permlane32_swap(a[1], b[1], false, false);
  u32x4 o = {s0[0], s1[0], s0[1], s1[1]};
  *(u32x4*)(p0 + 8 * hh) = o;
}

constexpr int NB = 4, SEQ = 4096, DM = 1024, NTOK = NB * SEQ;

constexpr size_t OFF_WTIN   = 0;
constexpr size_t OFF_WTOUT0 = OFF_WTIN + 6291456;
constexpr size_t OFF_WTOUT1 = OFF_WTOUT0 + 2097152;
constexpr size_t OFF_WSB    = OFF_WTOUT1 + 2097152;
constexpr size_t OFF_GT     = OFF_WSB + 262144;
constexpr size_t OFF_MODP   = OFF_GT + 65536;
constexpr size_t OFF_KSUM   = OFF_MODP + 1572864;
constexpr size_t OFF_CUM    = OFF_KSUM + 524288;
constexpr size_t OFF_AG     = OFF_CUM + 262144;
constexpr size_t OFF_TOT    = OFF_AG + 262144;
constexpr size_t OFF_HBUF   = OFF_TOT + 4096;
constexpr size_t OFF_PROJ   = OFF_HBUF + 33554432;
constexpr size_t OFF_MIX    = OFF_PROJ + 100663296;
constexpr size_t OFF_VT     = OFF_MIX;
constexpr size_t OFF_QM     = OFF_MIX + 16777216;
constexpr size_t OFF_KM     = OFF_QM + 16777216;
constexpr size_t OFF_VM     = OFF_KM + 16777216;
constexpr size_t OFF_XC     = OFF_VM + 16777216;
constexpr size_t OFF_UST    = OFF_XC + 16777216;
constexpr size_t OFF_END    = OFF_UST + 33816576;
constexpr size_t OFF_KT     = OFF_HBUF;
constexpr size_t OFF_GVT    = OFF_MIX;
constexpr size_t OFF_STATS  = OFF_MIX + 33554432;
constexpr size_t OFF_X1B    = OFF_MIX + 37748736;
constexpr size_t OFF_MODF   = OFF_END;
constexpr size_t OFF_BAR    = OFF_MODF + 98304;
static_assert(OFF_BAR + 16384 <= 268435456ull, "workspace overflow");

struct Params {
  const float *x, *c, *ln_g, *ada_w, *ada_b, *w_in, *w_out, *a_q_g, *a_k_g, *conv_w, *conv_b, *wq, *wk, *wv,
      *w_gates, *b_gates, *out_g, *skip, *c_ln_g, *c_ln_b, *c_ws, *c_bs;
  float* out;
  char* ws;
};

DI void transpose_tile(const float* __restrict__ src, bfu* __restrict__ dst, int K, int N, int k0, int n0, float* st) {
  const int tid = tid_l();
#pragma unroll
  for (int i = 0; i < 4; ++i) {
    const int r = (tid >> 4) + 16 * i, c4 = tid & 15;
    const float4 v = *(const float4*)(src + (size_t)(k0 + r) * N + n0 + 4 * c4);
    float* d = st + r * 65 + 4 * c4;
    d[0] = v.x; d[1] = v.y; d[2] = v.z; d[3] = v.w;
  }
  __syncthreads();
#pragma unroll
  for (int i = 0; i < 2; ++i) {
    const int n = (tid >> 3) + 32 * i, kc = tid & 7;
    float f[8];
#pragma unroll
    for (int j = 0; j < 8; ++j) f[j] = st[(8 * kc + j) * 65 + n];
    u32x4 o = {pack2(f[0], f[1]), pack2(f[2], f[3]), pack2(f[4], f[5]), pack2(f[6], f[7])};
    *(u32x4*)(dst + (size_t)(n0 + n) * K + k0 + 8 * kc) = o;
  }
  __syncthreads();
}

DI void mod_item(const Params& p, int it, float* sm) {
  const int layer = it / 192, rem = it % 192, cgp = rem >> 4, ks = rem & 15;
  const int tid = tid_l();
  {
    const int b = tid >> 6, kk = tid & 63;
    const float cv = p.c[b * 1024 + ks * 64 + kk];
    sm[tid] = silu_f(cv);
  }
  __syncthreads();
  const int col = cgp * 256 + tid;
  const float* w = p.ada_w + (size_t)layer * 1024 * 3072 + (size_t)(ks * 64) * 3072 + col;
  float a0 = 0.f, a1 = 0.f, a2 = 0.f, a3 = 0.f;
#pragma unroll 16
  for (int kk = 0; kk < 64; ++kk) {
    const float wv = w[(size_t)kk * 3072];
    a0 += sm[kk] * wv; a1 += sm[64 + kk] * wv; a2 += sm[128 + kk] * wv; a3 += sm[192 + kk] * wv;
  }
  float* o = (float*)(p.ws + OFF_MODP) + (size_t)((layer * 16 + ks) * 4) * 3072 + col;
  o[0] = a0; o[3072] = a1; o[2 * 3072] = a2; o[3 * 3072] = a3;
  __syncthreads();
}

DI void gt_item(const Params& p, int it) {
  const int ch = it * 256 + tid_l();
  bfu* gt = (bfu*)(p.ws + OFF_GT);
  for (int n = 0; n < 8; ++n) {
    float val = 0.f;
    if (ch < 512) {
      const int g = ch >> 2, ii = ch & 3;
      for (int o = 0; o < 4; ++o) {
        val += p.wq[g * 16 + ii * 4 + o] * p.w_gates[(4 * g + o) * 8 + n];
        val += p.wk[g * 16 + ii * 4 + o] * p.w_gates[(512 + 4 * g + o) * 8 + n];
      }
    } else {
      const int c2 = ch - 512, g = c2 >> 2, ii = c2 & 3;
      for (int o = 0; o < 4; ++o) val += p.wv[g * 16 + ii * 4 + o] * p.w_gates[(1024 + 4 * g + o) * 8 + n];
    }
    gt[n * 1024 + ch] = f2bf(val);
  }
  for (int n = 8; n < 32; ++n) gt[n * 1024 + ch] = 0;
}

DI void wsb_item(const Params& p, int it) {
  const int e = (it * 256 + tid_l()) * 8;
  const int t = (e >> 7) & 127, s0 = e & 127;
  float f[8];
#pragma unroll
  for (int j = 0; j < 8; ++j) f[j] = (s0 + j <= t) ? p.c_ws[e + j] : 0.f;
  u32x4 o = {pack2(f[0], f[1]), pack2(f[2], f[3]), pack2(f[4], f[5]), pack2(f[6], f[7])};
  *(u32x4*)((bfu*)(p.ws + OFF_WSB) + e) = o;
}

DI void norm_item(const Params& p, const float* __restrict__ xin, int layer, int it, float* sm) {
  float* sSc = sm;
  float* sSh = sm + 1024;
  const int tid = tid_l();
  const int row0 = it * 32;
  const int b = row0 >> 12;
  if (layer == 0) {
    const float* modp = (const float*)(p.ws + OFF_MODP);
#pragma unroll
    for (int cc = 0; cc < 4; ++cc) {
      const int col = tid + 256 * cc;
      float sc = p.ada_b[1024 + col], sh = p.ada_b[col];
#pragma unroll
      for (int ks = 0; ks < 16; ++ks) {
        const float* mp = modp + (size_t)(ks * 4 + b) * 3072;
        sc += mp[1024 + col];
        sh += mp[col];
      }
      sSc[col] = p.ln_g[col] * (1.f + sc);
      sSh[col] = sh;
    }
  } else {
    const float* mf = (const float*)(p.ws + OFF_MODF) + (size_t)(4 + b) * 3072;
#pragma unroll
    for (int cc = 0; cc < 4; ++cc) {
      const int col = tid + 256 * cc;
      sSc[col] = p.ln_g[1024 + col] * (1.f + mf[1024 + col]);
      sSh[col] = mf[col];
    }
  }
  __syncthreads();
  const int w = tid >> 6, lane = tid & 63;
  bfu* hb = (bfu*)(p.ws + OFF_HBUF);
#pragma unroll 1
  for (int rb = 0; rb < 2; ++rb) {
    const int rowb = row0 + w * 8 + rb * 4;
    float4 v[4][4];
    if (layer == 0) {
#pragma unroll
      for (int q = 0; q < 4; ++q)
#pragma unroll
        for (int j = 0; j < 4; ++j) v[q][j] = *(const float4*)(xin + (size_t)(rowb + q) * 1024 + lane * 4 + 256 * j);
    } else {
      const bfu* x1b = (const bfu*)(p.ws + OFF_X1B);
#pragma unroll
      for (int q = 0; q < 4; ++q)
#pragma unroll
        for (int j = 0; j < 4; ++j) {
          const u32x2 u = *(const u32x2*)(x1b + (size_t)(rowb + q) * 1024 + lane * 4 + 256 * j);
          v[q][j].x = bflo(u[0]); v[q][j].y = bfhi(u[0]); v[q][j].z = bflo(u[1]); v[q][j].w = bfhi(u[1]);
        }
    }
    float ss[4];
#pragma unroll
    for (int q = 0; q < 4; ++q) {
      float a = 0.f;
#pragma unroll
      for (int j = 0; j < 4; ++j) a += v[q][j].x * v[q][j].x + v[q][j].y * v[q][j].y + v[q][j].z * v[q][j].z + v[q][j].w * v[q][j].w;
      ss[q] = a;
    }
#pragma unroll
    for (int off = 32; off >= 1; off >>= 1)
#pragma unroll
      for (int q = 0; q < 4; ++q) ss[q] += __shfl_xor(ss[q], off);
#pragma unroll
    for (int q = 0; q < 4; ++q) {
      const float rstd = rsqrtf(ss[q] * (1.f / 1024.f) + 1e-6f);
#pragma unroll
      for (int j = 0; j < 4; ++j) {
        const int col = lane * 4 + 256 * j;
        const float4 sc4 = *(const float4*)(sSc + col);
        const float4 sh4 = *(const float4*)(sSh + col);
        const float y0 = v[q][j].x * rstd * sc4.x + sh4.x;
        const float y1 = v[q][j].y * rstd * sc4.y + sh4.y;
        const float y2 = v[q][j].z * rstd * sc4.z + sh4.z;
        const float y3 = v[q][j].w * rstd * sc4.w + sh4.w;
        u32x2 o = {pack2(y0, y1), pack2(y2, y3)};
        *(u32x2*)(hb + (size_t)(rowb + q) * 1024 + col) = o;
      }
    }
  }
  __syncthreads();
}

DI void modfin_item(const Params& p, int it) {
  const int idx = it * 256 + tid_l();
  const int layer = idx / 12288, rem = idx % 12288, b = rem / 3072, col = rem % 3072;
  const float* modp = (const float*)(p.ws + OFF_MODP);
  float a = p.ada_b[layer * 3072 + col];
#pragma unroll
  for (int ks = 0; ks < 16; ++ks) a += modp[(size_t)((layer * 16 + ks) * 4 + b) * 3072 + col];
  ((float*)(p.ws + OFF_MODF))[idx] = a;
}

#define GEMM_GL(KT)                                                                        \
  {                                                                                        \
    _Pragma("unroll") for (int i = 0; i < 8; ++i) ra[i] = *(const u32x4*)(ag + (size_t)i * 32 * K + (KT) * 64); \
    _Pragma("unroll") for (int i = 0; i < 4; ++i) rw[i] = *(const u32x4*)(wg + (size_t)i * 32 * K + (KT) * 64); \
  }
#define GEMM_LS()                                                                          \
  {                                                                                        \
    _Pragma("unroll") for (int i = 0; i < 8; ++i) *(u32x4*)(sA + ((EPI != 1) ? ldsa[i] : lds_w + i * 4096)) = ra[i]; \
    _Pragma("unroll") for (int i = 0; i < 4; ++i) *(u32x4*)(sW + lds_w + i * 4096) = rw[i]; \
  }
#define GEMM_COMPUTE()                                                                     \
  {                                                                                        \
    _Pragma("unroll") for (int kk = 0; kk < 4; ++kk) {                                     \
      bf16x8 fa[4], fw[2];                                                                 \
      const int sw = (((2 * kk + hh) ^ ((r >> 1) & 7)) << 4);                              \
      _Pragma("unroll") for (int mt = 0; mt < 4; ++mt)                                     \
        fa[mt] = *(const bf16x8*)(sA + (wm * 128 + mt * 32 + r) * 128 + sw);               \
      _Pragma("unroll") for (int nt = 0; nt < 2; ++nt)                                     \
        fw[nt] = *(const bf16x8*)(sW + (wn * 64 + nt * 32 + r) * 128 + sw);                \
      _Pragma("unroll") for (int nt = 0; nt < 2; ++nt)                                     \
        _Pragma("unroll") for (int mt = 0; mt < 4; ++mt)                                   \
          acc[nt][mt] = (EPI == 1) ? MFMA(fa[mt], fw[nt], acc[nt][mt]) : MFMA(fw[nt], fa[mt], acc[nt][mt]); \
    }                                                                                      \
  }

template <int EPI>
DI void gemm_tile(const Params& p, const bfu* __restrict__ A, const bfu* __restrict__ W, int m0, int n0, char* smem,
                  int layer, const float* __restrict__ resid) {
  constexpr int K = 1024;
  const int tid = tid_l(), lane = tid & 63, w = tid >> 6, r = lane & 31, hh = lane >> 5;
  const int wm = w & 1, wn = w >> 1;
  const int lrow = tid >> 3, lc = tid & 7;
  const bfu* ag = A + (size_t)(m0 + lrow) * K + lc * 8;
  const bfu* wg = W + (size_t)(n0 + lrow) * K + lc * 8;
  const int lds_w = lrow * 128 + ((lc ^ ((lrow >> 1) & 7)) << 4);
  int ldsa[8];
#pragma unroll
  for (int i = 0; i < 8; ++i) {
    const int prow = (i >> 2) * 128 + (2 * ((i & 3) >> 1) + (lrow & 1)) * 32 + (lrow >> 1) + 16 * (i & 1);
    ldsa[i] = prow * 128 + ((lc ^ ((prow >> 1) & 7)) << 4);
  }
#define GTOK(mt) (mw + 64 * ((mt) >> 1) + ((mt) & 1) + 2 * r)
  char* sA = smem;
  char* sW = smem + 32768;
  u32x4 ra[8], rw[4];
  GEMM_GL(0);
  float gate[2];
  if (EPI == 1) {
    const float* mf = (const float*)(p.ws + OFF_MODF) + (size_t)(layer * 4 + (m0 >> 12)) * 3072 + 2048 + n0 + wn * 64 + r;
    gate[0] = mf[0];
    gate[1] = mf[32];
  }
  f32x16 acc[2][4];
#pragma unroll
  for (int a = 0; a < 2; ++a)
#pragma unroll
    for (int b2 = 0; b2 < 4; ++b2)
#pragma unroll
      for (int i = 0; i < 16; ++i) acc[a][b2][i] = 0.f;
  GEMM_LS();
  __syncthreads();
#pragma unroll 1
  for (int kt = 0; kt < 16; ++kt) {
    const int kn = (kt + 1 < 16) ? kt + 1 : 15;
    GEMM_GL(kn);
    __builtin_amdgcn_sched_barrier(0);
    GEMM_COMPUTE();
    __syncthreads();
    GEMM_LS();
    __syncthreads();
  }

  const int nb = n0 + wn * 64;
  const int b = m0 >> 12;
  const int mw = m0 + wm * 128;
  bfu* proj = (bfu*)(p.ws + OFF_PROJ);
  if (EPI == 1) {
#pragma unroll
    for (int mt = 0; mt < 4; ++mt)
#pragma unroll
      for (int i = 0; i < 16; ++i) {
        const int token = mw + mt * 32 + crow(i, hh);
        const size_t off = (size_t)token * 1024 + nb + r;
        if (layer == 0) {
          const float r0 = resid[off], r1 = resid[off + 32];
          bfu* x1b = (bfu*)(p.ws + OFF_X1B);
          x1b[off] = f2bf(r0 + gate[0] * acc[0][mt][i]);
          x1b[off + 32] = f2bf(r1 + gate[1] * acc[1][mt][i]);
        } else {
          const bfu* x1b = (const bfu*)(p.ws + OFF_X1B);
          const float r0 = bf2f(x1b[off]), r1 = bf2f(x1b[off + 32]);
          p.out[off] = r0 + gate[0] * acc[0][mt][i];
          p.out[off + 32] = r1 + gate[1] * acc[1][mt][i];
        }
      }
  } else if (EPI == 0) {
    if (nb < 1024) {
      const bool isk = nb >= 512;
      const float* gg = isk ? p.a_k_g : p.a_q_g;
      float gv[2][16], cs[2][16];
#pragma unroll
      for (int nt = 0; nt < 2; ++nt)
#pragma unroll
        for (int i = 0; i < 16; ++i) { gv[nt][i] = gg[nt * 32 + crow(i, hh)]; cs[nt][i] = 0.f; }
#pragma unroll
      for (int mt = 0; mt < 4; ++mt) {
        float ss = 0.f;
#pragma unroll
        for (int nt = 0; nt < 2; ++nt)
#pragma unroll
          for (int i = 0; i < 16; ++i) ss += acc[nt][mt][i] * acc[nt][mt][i];
        ss += __shfl_xor(ss, 32);
        const float rstd = rsqrtf(ss * (1.f / 64.f) + 1e-6f);
        const int token = GTOK(mt);
        bfu* dst = proj + (size_t)token * 3072 + nb;
#pragma unroll
        for (int nt = 0; nt < 2; ++nt) {
          u32x2 ob[4];
#pragma unroll
          for (int g4 = 0; g4 < 4; ++g4) {
            float v[4];
#pragma unroll
            for (int q = 0; q < 4; ++q) {
              v[q] = acc[nt][mt][4 * g4 + q] * rstd * gv[nt][4 * g4 + q];
              cs[nt][4 * g4 + q] += v[q];
            }
            ob[g4][0] = pack2(v[0], v[1]); ob[g4][1] = pack2(v[2], v[3]);
          }
          store_pair16(dst + nt * 32, ob[0], ob[1], hh);
          store_pair16(dst + nt * 32 + 16, ob[2], ob[3], hh);
        }
      }
      if (isk) {
        const int head = (nb - 512) >> 6;
        const int tokblk = (mw & 4095) >> 7;
        float* ks = (float*)(p.ws + OFF_KSUM) + (size_t)((b * 8 + head) * 32 + tokblk) * 64;
#pragma unroll
        for (int nt = 0; nt < 2; ++nt)
#pragma unroll
          for (int i = 0; i < 16; ++i) {
            float v = cs[nt][i];
#pragma unroll
            for (int off = 1; off < 32; off <<= 1) v += __shfl_xor(v, off);
            if (r == 0) ks[nt * 32 + crow(i, hh)] = v;
          }
      }
    } else if (nb < 1536) {
      const int head = (nb - 1024) >> 6;
      bfu* vt = (bfu*)(p.ws + OFF_VT) + (size_t)((b * 8 + head) * 64) * 4096;
#pragma unroll
      for (int nt = 0; nt < 2; ++nt)
#pragma unroll
        for (int a = 0; a < 2; ++a) {
          const int s0 = (mw & 4095) + 64 * a + 2 * r;
#pragma unroll
          for (int i = 0; i < 16; ++i)
            *(unsigned*)(vt + (size_t)(nt * 32 + crow(i, hh)) * 4096 + s0) = pack2(acc[nt][2 * a][i], acc[nt][2 * a + 1][i]);
        }
    } else {
      const bool act = (nb < 2048) || (nb >= 2560);
#pragma unroll
      for (int nt = 0; nt < 2; ++nt)
#pragma unroll
        for (int mt = 0; mt < 4; ++mt) {
          const int token = GTOK(mt);
          bfu* dst = proj + (size_t)token * 3072 + nb + nt * 32;
          u32x2 ob[4];
#pragma unroll
          for (int g4 = 0; g4 < 4; ++g4) {
            float v[4];
#pragma unroll
            for (int q = 0; q < 4; ++q) { v[q] = acc[nt][mt][4 * g4 + q]; if (act) v[q] = silu_f(v[q]); }
            ob[g4][0] = pack2(v[0], v[1]); ob[g4][1] = pack2(v[2], v[3]);
          }
          store_pair16(dst, ob[0], ob[1], hh);
          store_pair16(dst + 16, ob[2], ob[3], hh);
        }
    }
  } else {
    if (nb >= 1024 && nb < 2048) {
      const int c0 = nb - 1024;
      bfu* gvt = (bfu*)(p.ws + OFF_GVT) + (size_t)(b * 1024 + c0) * 4096;
      float* stats = (float*)(p.ws + OFF_STATS);
#pragma unroll
      for (int mt = 0; mt < 4; ++mt) {
        const int token = GTOK(mt);
        float s1 = 0.f, s2 = 0.f;
#pragma unroll
        for (int nt = 0; nt < 2; ++nt)
#pragma unroll
          for (int i = 0; i < 16; ++i) {
            const float v = gelu_f(acc[nt][mt][i]);
            s1 += v; s2 += v * v;
            acc[nt][mt][i] = v;
          }
        s1 += __shfl_xor(s1, 32);
        s2 += __shfl_xor(s2, 32);
        if (hh == 0) {
          float2 o; o.x = s1; o.y = s2;
          *(float2*)(stats + ((size_t)token * 16 + (c0 >> 6)) * 2) = o;
        }
      }
#pragma unroll
      for (int nt = 0; nt < 2; ++nt)
#pragma unroll
        for (int a = 0; a < 2; ++a) {
          const int s0 = (mw & 4095) + 64 * a + 2 * r;
#pragma unroll
          for (int i = 0; i < 16; ++i)
            *(unsigned*)(gvt + (size_t)(nt * 32 + crow(i, hh)) * 4096 + s0) = pack2(acc[nt][2 * a][i], acc[nt][2 * a + 1][i]);
        }
    } else {
      const bool isu = nb < 1024;
#pragma unroll
      for (int nt = 0; nt < 2; ++nt)
#pragma unroll
        for (int mt = 0; mt < 4; ++mt) {
          const int token = GTOK(mt);
          bfu* dst = proj + (size_t)token * 3072 + nb + nt * 32;
          u32x2 ob[4];
#pragma unroll
          for (int g4 = 0; g4 < 4; ++g4) {
            float v[4];
#pragma unroll
            for (int q = 0; q < 4; ++q) { const float a = acc[nt][mt][4 * g4 + q]; v[q] = isu ? gelu_f(a) : silu_f(a); }
            ob[g4][0] = pack2(v[0], v[1]); ob[g4][1] = pack2(v[2], v[3]);
          }
          store_pair16(dst, ob[0], ob[1], hh);
          store_pair16(dst + 16, ob[2], ob[3], hh);
        }
    }
  }
}

#undef GTOK
DI void mlstm_prep_item(const Params& p, int it, char* smem) {
  const int tid = tid_l(), lane = tid & 63, w = __builtin_amdgcn_readfirstlane(tid >> 6), r = lane & 31, hh = lane >> 5;
  const int b = it >> 6, c = it & 63;
  const int tok0 = b * 4096 + c * 64;
  const bfu* proj = (const bfu*)(p.ws + OFF_PROJ);
  bfu* qm = (bfu*)(p.ws + OFF_QM);
  bfu* km = (bfu*)(p.ws + OFF_KM);
  bfu* vm = (bfu*)(p.ws + OFF_VM);
  bfu* xcb = (bfu*)(p.ws + OFF_XC);
  bfu* ktm = (bfu*)(p.ws + OFF_KT);
  float* sG = (float*)smem;
  float* sWt = (float*)(smem + 8192);
  {
    const int blk = tid & 127, th = tid >> 7;
    const int ch = blk * 4;
    float cw[4][4], cb[4], q_w[4][4], k_w[4][4], v_w[4][4];
#pragma unroll
    for (int j = 0; j < 4; ++j)
#pragma unroll
      for (int i = 0; i < 4; ++i) {
        cw[j][i] = p.conv_w[j * 512 + ch + i];
        q_w[j][i] = p.wq[blk * 16 + j * 4 + i];
        k_w[j][i] = p.wk[blk * 16 + j * 4 + i];
        v_w[j][i] = p.wv[blk * 16 + j * 4 + i];
      }
#pragma unroll
    for (int i = 0; i < 4; ++i) cb[i] = p.conv_b[ch + i];
    float win[4][4];
    const int sl0 = c * 64 + th * 32;
#pragma unroll
    for (int j = 0; j < 3; ++j) {
      const int sp = sl0 - 3 + j;
      if (sp >= 0) {
        const u32x2 v = *(const u32x2*)(proj + (size_t)(b * 4096 + sp) * 3072 + 2048 + ch);
        win[j][0] = bflo(v[0]); win[j][1] = bfhi(v[0]); win[j][2] = bflo(v[1]); win[j][3] = bfhi(v[1]);
      } else {
        win[j][0] = win[j][1] = win[j][2] = win[j][3] = 0.f;
      }
    }
    const float kscale = 0.08838834764831845f;
    const bfu* bxp = proj + ((size_t)b * 4096 + sl0) * 3072 + 2048 + ch;
    u32x2 cur[8], nxt[8];
    float kk8[4][8], vv8[4][8];
#pragma unroll
    for (int q = 0; q < 8; ++q) cur[q] = *(const u32x2*)(bxp + (size_t)q * 3072);
#pragma unroll 1
    for (int t8 = 0; t8 < 4; ++t8) {
      const int tn = (t8 < 3) ? (t8 + 1) * 8 : 24;
#pragma unroll
      for (int q = 0; q < 8; ++q) nxt[q] = *(const u32x2*)(bxp + (size_t)(tn + q) * 3072);
      __builtin_amdgcn_sched_barrier(0);
#pragma unroll
      for (int q = 0; q < 8; ++q) {
        const size_t token = (size_t)b * 4096 + sl0 + t8 * 8 + q;
        const u32x2 v = cur[q];
        win[3][0] = bflo(v[0]); win[3][1] = bfhi(v[0]); win[3][2] = bflo(v[1]); win[3][3] = bfhi(v[1]);
        float xc[4], bq[4], bk[4], bv[4];
#pragma unroll
        for (int i = 0; i < 4; ++i) {
          float a = cb[i];
#pragma unroll
          for (int j = 0; j < 4; ++j) a += cw[j][i] * win[j][i];
          xc[i] = silu_f(a);
        }
#pragma unroll
        for (int o = 0; o < 4; ++o) {
          float aq = 0.f, ak = 0.f, av = 0.f;
#pragma unroll
          for (int i = 0; i < 4; ++i) { aq += xc[i] * q_w[i][o]; ak += xc[i] * k_w[i][o]; av += win[3][i] * v_w[i][o]; }
          bq[o] = aq; bk[o] = ak * kscale; bv[o] = av;
        }
        u32x2 o;
        o[0] = pack2(bq[0], bq[1]); o[1] = pack2(bq[2], bq[3]); *(u32x2*)(qm + token * 512 + ch) = o;
        o[0] = pack2(bk[0], bk[1]); o[1] = pack2(bk[2], bk[3]); *(u32x2*)(km + token * 512 + ch) = o;
#pragma unroll
        for (int o4 = 0; o4 < 4; ++o4) { kk8[o4][q] = bk[o4]; vv8[o4][q] = bv[o4]; }
        o[0] = pack2(xc[0], xc[1]); o[1] = pack2(xc[2], xc[3]); *(u32x2*)(xcb + token * 512 + ch) = o;
#pragma unroll
        for (int j = 0; j < 3; ++j)
#pragma unroll
          for (int i = 0; i < 4; ++i) win[j][i] = win[j + 1][i];
      }
#pragma unroll
      for (int o4 = 0; o4 < 4; ++o4) {
        const size_t off = ((size_t)((b * 4 + (blk >> 5)) * 64 + c) * 128 + (blk & 31) * 4 + o4) * 64 + th * 32 + t8 * 8;
        u32x4 pk = {pack2(kk8[o4][0], kk8[o4][1]), pack2(kk8[o4][2], kk8[o4][3]), pack2(kk8[o4][4], kk8[o4][5]), pack2(kk8[o4][6], kk8[o4][7])};
        *(u32x4*)(ktm + off) = pk;
        u32x4 pv = {pack2(vv8[o4][0], vv8[o4][1]), pack2(vv8[o4][2], vv8[o4][3]), pack2(vv8[o4][4], vv8[o4][5]), pack2(vv8[o4][6], vv8[o4][7])};
        *(u32x4*)(vm + off) = pv;
      }
#pragma unroll
      for (int q = 0; q < 8; ++q) cur[q] = nxt[q];
    }
  }
  __threadfence_block();
  __syncthreads();
  {
    const bfu* gt = (const bfu*)(p.ws + OFF_GT);
    f32x16 acc[2];
#pragma unroll
    for (int tt = 0; tt < 2; ++tt)
#pragma unroll
      for (int i = 0; i < 16; ++i) acc[tt][i] = 0.f;
#pragma unroll 4
    for (int ksi = 0; ksi < 16; ++ksi) {
      const int ch = (16 * w + ksi) * 16 + 8 * hh;
      const bf16x8 af = as_frag(*(const u32x4*)(gt + r * 1024 + ch));
#pragma unroll
      for (int tt = 0; tt < 2; ++tt) {
        const size_t token = (size_t)tok0 + 32 * tt + r;
        const bfu* src = (ch < 512) ? (xcb + token * 512 + ch) : (proj + token * 3072 + 2048 + (ch - 512));
        const bf16x8 bfr = as_frag(*(const u32x4*)src);
        acc[tt] = MFMA(af, bfr, acc[tt]);
      }
    }
#pragma unroll
    for (int tt = 0; tt < 2; ++tt)
#pragma unroll
      for (int i = 0; i < 4; ++i) sG[(w * 8 + 4 * hh + i) * 64 + 32 * tt + r] = acc[tt][i];
  }
  __syncthreads();
  {
    const int head = w, tok = lane;
    float ig = p.b_gates[head], fg = p.b_gates[4 + head];
#pragma unroll
    for (int ww = 0; ww < 4; ++ww) { ig += sG[(ww * 8 + head) * 64 + tok]; fg += sG[(ww * 8 + 4 + head) * 64 + tok]; }
    const float lf = fminf(fg, 0.f) - log1pf(__expf(-fabsf(fg)));
    float cum = lf;
#pragma unroll
    for (int off = 1; off < 64; off <<= 1) {
      const float o = __shfl_up(cum, off);
      if (lane >= off) cum += o;
    }
    const float tot = __shfl(cum, 63);
    const float a = ig - cum;
    const int bh = b * 4 + head;
    ((float*)(p.ws + OFF_CUM))[(size_t)bh * 4096 + c * 64 + tok] = cum;
    ((float*)(p.ws + OFF_AG))[(size_t)bh * 4096 + c * 64 + tok] = a;
    if (lane == 0) ((float*)(p.ws + OFF_TOT))[bh * 64 + c] = tot;
    sWt[head * 64 + tok] = __expf(tot + a);
  }
  __syncthreads();
  {
    const int h = w;
    const int bh = b * 4 + h;
    const bfu* ktc = ktm + (size_t)(bh * 64 + c) * 128 * 64;
    const bfu* vtc = vm + (size_t)(bh * 64 + c) * 128 * 64;
    bfu* ust = (bfu*)(p.ws + OFF_UST) + (size_t)(bh * 64 + c) * 129 * 128;
    float wsr[4][8];
#pragma unroll
    for (int ss = 0; ss < 4; ++ss)
#pragma unroll
      for (int j = 0; j < 8; ++j) wsr[ss][j] = sWt[h * 64 + 16 * ss + 8 * hh + j];
    u32x4 vall[4][4];
#pragma unroll
    for (int vt = 0; vt < 4; ++vt)
#pragma unroll
      for (int ss = 0; ss < 4; ++ss) vall[vt][ss] = *(const u32x4*)(vtc + (size_t)(vt * 32 + r) * 64 + 16 * ss + 8 * hh);
    bf16x8 kall[4][4];
#pragma unroll
    for (int kt = 0; kt < 4; ++kt)
#pragma unroll
      for (int ss = 0; ss < 4; ++ss) kall[kt][ss] = as_frag(*(const u32x4*)(ktc + (size_t)(kt * 32 + r) * 64 + 16 * ss + 8 * hh));
#pragma unroll
    for (int vt = 0; vt < 5; ++vt) {
      bf16x8 vf[4];
#pragma unroll
      for (int ss = 0; ss < 4; ++ss) {
        float f[8];
        if (vt < 4) {
#pragma unroll
          for (int q = 0; q < 4; ++q) { f[2 * q] = bflo(vall[vt < 4 ? vt : 0][ss][q]) * wsr[ss][2 * q]; f[2 * q + 1] = bfhi(vall[vt < 4 ? vt : 0][ss][q]) * wsr[ss][2 * q + 1]; }
        } else {
#pragma unroll
          for (int j = 0; j < 8; ++j) f[j] = (r == 0) ? wsr[ss][j] : 0.f;
        }
        u32x4 pk = {pack2(f[0], f[1]), pack2(f[2], f[3]), pack2(f[4], f[5]), pack2(f[6], f[7])};
        vf[ss] = as_frag(pk);
      }
#pragma unroll
      for (int kp = 0; kp < 2; ++kp) {
        f32x16 acc[2];
#pragma unroll
        for (int kt = 0; kt < 2; ++kt)
#pragma unroll
          for (int i = 0; i < 16; ++i) acc[kt][i] = 0.f;
#pragma unroll
        for (int ss = 0; ss < 4; ++ss)
#pragma unroll
          for (int kt = 0; kt < 2; ++kt) acc[kt] = MFMA(kall[kp * 2 + kt][ss], vf[ss], acc[kt]);
#pragma unroll
        for (int kt = 0; kt < 2; ++kt)
#pragma unroll
          for (int gp = 0; gp < 2; ++gp) {
            u32x2 oa = {pack2(acc[kt][8 * gp], acc[kt][8 * gp + 1]), pack2(acc[kt][8 * gp + 2], acc[kt][8 * gp + 3])};
            u32x2 obb = {pack2(acc[kt][8 * gp + 4], acc[kt][8 * gp + 5]), pack2(acc[kt][8 * gp + 6], acc[kt][8 * gp + 7])};
            const auto s0 = __builtin_amdgcn_permlane32_swap(oa[0], obb[0], false, false);
            const auto s1 = __builtin_amdgcn_permlane32_swap(oa[1], obb[1], false, false);
            u32x4 o = {s0[0], s1[0], s0[1], s1[1]};
            if (vt < 4 || r == 0) *(u32x4*)(ust + (size_t)(vt * 32 + r) * 128 + (kp * 2 + kt) * 32 + 16 * gp + 8 * hh) = o;
          }
      }
    }
  }
  __syncthreads();
}

DI void scan_item(const Params& p, int it) {
  const int id = it * 256 + tid_l();
  const int bh = id / 2064, e8 = id % 2064;
  bfu* base = (bfu*)(p.ws + OFF_UST) + (size_t)bh * 64 * 16512 + e8 * 8;
  const float* tot = (const float*)(p.ws + OFF_TOT) + bh * 64;
  float st[8];
#pragma unroll
  for (int j = 0; j < 8; ++j) st[j] = 0.f;
  for (int c0 = 0; c0 < 64; c0 += 8) {
    u32x4 u[8];
#pragma unroll
    for (int j = 0; j < 8; ++j) u[j] = *(const u32x4*)(base + (size_t)(c0 + j) * 16512);
#pragma unroll
    for (int j = 0; j < 8; ++j) {
      u32x4 o = {pack2(st[0], st[1]), pack2(st[2], st[3]), pack2(st[4], st[5]), pack2(st[6], st[7])};
      *(u32x4*)(base + (size_t)(c0 + j) * 16512) = o;
      const float dec = __expf(tot[c0 + j]);
#pragma unroll
      for (int q = 0; q < 4; ++q) {
        st[2 * q] = dec * st[2 * q] + bflo(u[j][q]);
        st[2 * q + 1] = dec * st[2 * q + 1] + bfhi(u[j][q]);
      }
    }
  }
}

DI void moba_item(const Params& p, int mi, char* smem) {
  const int tid = tid_l(), lane = tid & 63, w = tid >> 6, r = lane & 31, hh = lane >> 5;
  const int jb = 15 - (mi >> 6);
  const int rem = mi & 63;
  const int half = 1 - (rem >> 5);
  const int bh = rem & 31;
  const int b = bh >> 3, h = bh & 7;
  const int q0 = jb * 256 + half * 128;
  const size_t tokbase = (size_t)b * 4096;
  const bfu* proj = (const bfu*)(p.ws + OFF_PROJ);
  const bfu* vtg = (const bfu*)(p.ws + OFF_VT) + (size_t)bh * 64 * 4096;
  float* sKM = (float*)smem;
  char* sK = smem + 4096;
  char* sV = smem + 4096 + 24576;
  {
    const float* ks = (const float*)(p.ws + OFF_KSUM) + (size_t)bh * 32 * 64;
    for (int idx = tid; idx < jb * 64; idx += 256) {
      const int n = idx >> 6, d = idx & 63;
      const float* q2 = ks + (size_t)(2 * n) * 64 + d;
      sKM[idx] = q2[0] + q2[64];
    }
  }
  const int qpos = q0 + w * 32 + r;
  const size_t qtoken = tokbase + qpos;
  u32x4 qf[4];
#pragma unroll
  for (int kk = 0; kk < 4; ++kk) qf[kk] = *(const u32x4*)(proj + qtoken * 3072 + h * 64 + kk * 16 + hh * 8);
  __syncthreads();
  unsigned sel;
  {
    float s1 = -INFINITY, s2 = -INFINITY, s3 = -INFINITY;
    int i1 = -1, i2 = -1, i3 = -1;
    for (int n = 0; n < jb; ++n) {
      float dot = 0.f;
#pragma unroll
      for (int kk = 0; kk < 4; ++kk) {
        const float* km = sKM + n * 64 + kk * 16 + hh * 8;
#pragma unroll
        for (int e = 0; e < 4; ++e) {
          dot += bflo(qf[kk][e]) * km[2 * e];
          dot += bfhi(qf[kk][e]) * km[2 * e + 1];
        }
      }
      dot += __shfl_xor(dot, 32);
      if (dot > s1) { s3 = s2; i3 = i2; s2 = s1; i2 = i1; s1 = dot; i1 = n; }
      else if (dot > s2) { s3 = s2; i3 = i2; s2 = dot; i2 = n; }
      else if (dot > s3) { s3 = dot; i3 = n; }
    }
    if (jb <= 3) sel = (1u << jb) - 1u;
    else sel = (1u << i1) | (1u << i2) | (1u << i3);
  }
  const int ntile = 4 * jb + (half ? 4 : 2);
  const int lrow = tid >> 3, lch = tid & 7;
  u32x4 kregA[2], vregA[2], kregB[2], vregB[2];
  auto gload = [&](int tix, u32x4 (&kreg)[2], u32x4 (&vreg)[2]) {
    const int n = tix >> 2, tk = tix & 3;
    const int key0 = n * 256 + tk * 64;
#pragma unroll
    for (int i = 0; i < 2; ++i) {
      const int row = lrow + 32 * i;
      kreg[i] = *(const u32x4*)(proj + (tokbase + key0 + row) * 3072 + 512 + h * 64 + lch * 8);
      vreg[i] = *(const u32x4*)(vtg + (size_t)row * 4096 + key0 + lch * 8);
    }
  };
  auto lstore = [&](int buf, u32x4 (&kreg)[2], u32x4 (&vreg)[2]) {
#pragma unroll
    for (int i = 0; i < 2; ++i) {
      const int row = lrow + 32 * i;
      const int sw = (row >> 1) & 7;
      *(u32x4*)(sK + buf * 8192 + row * 128 + ((lch ^ sw) << 4)) = kreg[i];
      const int g = lch >> 1, hf = (lch & 1) << 3;
      u32x2 lo = {vreg[i][0], vreg[i][1]}, hi = {vreg[i][2], vreg[i][3]};
      *(u32x2*)(sV + buf * 8192 + row * 128 + (((2 * g) ^ sw) << 4) + hf) = lo;
      *(u32x2*)(sV + buf * 8192 + row * 128 + (((2 * g + 1) ^ sw) << 4) + hf) = hi;
    }
  };
  const f32x16 zero16 = {0.f, 0.f, 0.f, 0.f, 0.f, 0.f, 0.f, 0.f, 0.f, 0.f, 0.f, 0.f, 0.f, 0.f, 0.f, 0.f};
  const int qmax = q0 + w * 32 + 31;
  int lofs[4];
#pragma unroll
  for (int g = 0; g < 4; ++g) lofs[g] = r * 128 + (((2 * g + hh) ^ ((r >> 1) & 7)) << 4);
  auto compute_s = [&](int tix, int buf, f32x16 (&s)[2]) {
    const int key0 = (tix >> 2) * 256 + (tix & 3) * 64;
    if (key0 <= qmax) {
      const char* kb = sK + buf * 8192;
      const bool two = (key0 + 32 <= qmax);
      if ((tix >> 2) == jb) {
        const int lim = qpos - key0 - 4 * hh;
        f32x16 b0, b1;
#pragma unroll
        for (int i = 0; i < 16; ++i) {
          const int cidx = (i & 3) + 8 * (i >> 2);
          b0[i] = (cidx <= lim) ? 0.f : -INFINITY;
          b1[i] = (two && (32 + cidx <= lim)) ? 0.f : -INFINITY;
        }
        s[0] = MFMA(*(const bf16x8*)(kb + lofs[0]), as_frag(qf[0]), b0);
#pragma unroll
        for (int kk = 1; kk < 4; ++kk) s[0] = MFMA(*(const bf16x8*)(kb + lofs[kk]), as_frag(qf[kk]), s[0]);
        if (two) {
          s[1] = MFMA(*(const bf16x8*)(kb + 4096 + lofs[0]), as_frag(qf[0]), b1);
#pragma unroll
          for (int kk = 1; kk < 4; ++kk) s[1] = MFMA(*(const bf16x8*)(kb + 4096 + lofs[kk]), as_frag(qf[kk]), s[1]);
        } else {
          s[1] = b1;
        }
      } else {
        s[0] = MFMA(*(const bf16x8*)(kb + lofs[0]), as_frag(qf[0]), zero16);
#pragma unroll
        for (int kk = 1; kk < 4; ++kk) s[0] = MFMA(*(const bf16x8*)(kb + lofs[kk]), as_frag(qf[kk]), s[0]);
        s[1] = MFMA(*(const bf16x8*)(kb + 4096 + lofs[0]), as_frag(qf[0]), zero16);
#pragma unroll
        for (int kk = 1; kk < 4; ++kk) s[1] = MFMA(*(const bf16x8*)(kb + 4096 + lofs[kk]), as_frag(qf[kk]), s[1]);
      }
    }
  };
  f32x16 oacc[2];
#pragma unroll
  for (int dt = 0; dt < 2; ++dt)
#pragma unroll
    for (int i = 0; i < 16; ++i) oacc[dt][i] = 0.f;
  float mrun = -1e30f;
  f32x16 lacc = zero16;
  const unsigned onev = (r == 0) ? 0x3F803F80u : 0u;
  const u32x4 ones4 = {onev, onev, onev, onev};
  const bf16x8 onesf = as_frag(ones4);
  const float cs = 0.125f * 1.4426950408889634f;
  auto step = [&](int tix, int b0, int b1, int b2, f32x16 (&scur)[2], f32x16 (&snext)[2], u32x4 (&kreg)[2], u32x4 (&vreg)[2]) {
    if (tix + 1 < ntile) compute_s(tix + 1, b1, snext);
    const int n = tix >> 2, tk = tix & 3;
    const int key0 = n * 256 + tk * 64;
    if (key0 <= qmax) {
      const char* vb = sV + b0 * 8192;
      const bool own = (n == jb);
      const bool lsel = own || ((sel >> n) & 1u);
      const bool act1 = (key0 + 32 <= qmax);
      float mt = scur[0][0];
#pragma unroll
      for (int i = 1; i < 16; ++i) mt = fmaxf(mt, scur[0][i]);
#pragma unroll
      for (int i = 0; i < 16; ++i) mt = fmaxf(mt, scur[1][i]);
      mt = fmaxf(mt, __shfl_xor(mt, 32));
      mt = lsel ? mt : -INFINITY;
      const float mnew = fmaxf(mrun, mt);
      const float alpha = __builtin_amdgcn_exp2f((mrun - mnew) * cs);
      mrun = mnew;
      const float nbias = (lsel && mnew > -1e29f) ? -mnew * cs : -INFINITY;
#pragma unroll
      for (int kt = 0; kt < 2; ++kt)
#pragma unroll
        for (int i = 0; i < 16; ++i) scur[kt][i] = __builtin_amdgcn_exp2f(__builtin_fmaf(scur[kt][i], cs, nbias));
      lacc[0] *= alpha;
#pragma unroll
      for (int dt = 0; dt < 2; ++dt)
#pragma unroll
        for (int i = 0; i < 16; ++i) oacc[dt][i] *= alpha;
#pragma unroll
      for (int kt = 0; kt < 2; ++kt) {
        if (kt == 0 || act1) {
#pragma unroll
          for (int ss = 0; ss < 2; ++ss) {
            u32x4 pk = {pack2(scur[kt][8 * ss], scur[kt][8 * ss + 1]), pack2(scur[kt][8 * ss + 2], scur[kt][8 * ss + 3]),
                        pack2(scur[kt][8 * ss + 4], scur[kt][8 * ss + 5]), pack2(scur[kt][8 * ss + 6], scur[kt][8 * ss + 7])};
            const bf16x8 pf = as_frag(pk);
#pragma unroll
            for (int dt = 0; dt < 2; ++dt) {
              const bf16x8 vf = *(const bf16x8*)(vb + dt * 4096 + lofs[2 * kt + ss]);
              oacc[dt] = MFMA(vf, pf, oacc[dt]);
            }
            lacc = MFMA(onesf, pf, lacc);
          }
        }
      }
    }
    lstore(b2, kreg, vreg);
    gload((tix + 4 < ntile) ? tix + 4 : ntile - 1, kreg, vreg);
    __syncthreads();
  };
  gload(0, kregA, vregA);
  gload(1, kregB, vregB);
  lstore(0, kregA, vregA);
  gload((2 < ntile) ? 2 : ntile - 1, kregA, vregA);
  lstore(1, kregB, vregB);
  gload((3 < ntile) ? 3 : ntile - 1, kregB, vregB);
  __syncthreads();
  f32x16 sa[2], sb[2];
  sa[0] = zero16; sa[1] = zero16; sb[0] = zero16; sb[1] = zero16;
  compute_s(0, 0, sa);
  {
    int b0 = 0;
#pragma unroll 1
    for (int tix = 0; tix < ntile; tix += 2) {
      const int b1 = (b0 == 2) ? 0 : b0 + 1;
      const int b2 = (b1 == 2) ? 0 : b1 + 1;
      step(tix, b0, b1, b2, sa, sb, kregA, vregA);
      if (tix + 1 < ntile) step(tix + 1, b1, b2, b0, sb, sa, kregB, vregB);
      b0 = b2;
    }
  }
  {
    const float ltot = __shfl(lacc[0], r);
    const float inv = 1.f / ltot;
    bfu* ym = (bfu*)(p.ws + OFF_HBUF);
#pragma unroll
    for (int dt = 0; dt < 2; ++dt) {
      u32x2 ob[4], azp[4];
      load_pair16(proj + qtoken * 3072 + 1536 + h * 64 + dt * 32, hh, azp[0], azp[1]);
      load_pair16(proj + qtoken * 3072 + 1536 + h * 64 + dt * 32 + 16, hh, azp[2], azp[3]);
#pragma unroll
      for (int g4 = 0; g4 < 4; ++g4) {
        const u32x2 az = azp[g4];
        const float y0 = oacc[dt][4 * g4] * inv * bflo(az[0]);
        const float y1 = oacc[dt][4 * g4 + 1] * inv * bfhi(az[0]);
        const float y2 = oacc[dt][4 * g4 + 2] * inv * bflo(az[1]);
        const float y3 = oacc[dt][4 * g4 + 3] * inv * bfhi(az[1]);
        ob[g4][0] = pack2(y0, y1); ob[g4][1] = pack2(y2, y3);
      }
      store_pair16(ym + qtoken * 1024 + h * 64 + dt * 32, ob[0], ob[1], hh);
      store_pair16(ym + qtoken * 1024 + h * 64 + dt * 32 + 16, ob[2], ob[3], hh);
    }
  }
}

DI void mlstm_out_item(const Params& p, int it) {
  const int lane = tid_l() & 63, r = lane & 31, hh = lane >> 5;
  const int bh = it >> 7, c = (it >> 1) & 63, tt = it & 1;
  const int b = bh >> 2, h = bh & 3;
  const size_t tok0 = (size_t)b * 4096 + c * 64;
  const bfu* proj = (const bfu*)(p.ws + OFF_PROJ);
  const bfu* qm = (const bfu*)(p.ws + OFF_QM);
  const bfu* km = (const bfu*)(p.ws + OFF_KM);
  const bfu* vm = (const bfu*)(p.ws + OFF_VM);
  const bfu* xcb = (const bfu*)(p.ws + OFF_XC);
  const bfu* cst = (const bfu*)(p.ws + OFF_UST) + (size_t)(bh * 64 + c) * 129 * 128;
  const float* cumv = (const float*)(p.ws + OFF_CUM) + (size_t)bh * 4096 + c * 64;
  const float* agv = (const float*)(p.ws + OFF_AG) + (size_t)bh * 4096 + c * 64;
  bfu* ym = (bfu*)(p.ws + OFF_HBUF);
  {
    const size_t token = tok0 + 32 * tt + r;
    u32x4 qf[8];
#pragma unroll
    for (int kk = 0; kk < 8; ++kk) qf[kk] = *(const u32x4*)(qm + token * 512 + h * 128 + 16 * kk + 8 * hh);
    const float cum_t = cumv[32 * tt + r];
    const float e_t = __expf(cum_t);
    float dn;
    {
      f32x16 an;
#pragma unroll
      for (int i = 0; i < 16; ++i) an[i] = 0.f;
#pragma unroll
      for (int kk = 0; kk < 8; ++kk) {
        u32x4 cv = {0u, 0u, 0u, 0u};
        if (r == 0) cv = *(const u32x4*)(cst + (size_t)128 * 128 + 16 * kk + 8 * hh);
        an = MFMA(as_frag(cv), as_frag(qf[kk]), an);
      }
      dn = __shfl(an[0], r);
    }
    f32x16 ai[4];
#pragma unroll
    for (int vt = 0; vt < 4; ++vt) {
#pragma unroll
      for (int i = 0; i < 16; ++i) ai[vt][i] = 0.f;
#pragma unroll
      for (int kk = 0; kk < 8; ++kk) {
        const u32x4 cv = *(const u32x4*)(cst + (size_t)(vt * 32 + r) * 128 + 16 * kk + 8 * hh);
        ai[vt] = MFMA(as_frag(cv), as_frag(qf[kk]), ai[vt]);
      }
#pragma unroll
      for (int i = 0; i < 16; ++i) ai[vt][i] *= e_t;
    }
    float den_i = 0.f;
#pragma unroll 1
    for (int st = 0; st <= tt; ++st) {
      f32x16 sacc;
#pragma unroll
      for (int i = 0; i < 16; ++i) sacc[i] = 0.f;
#pragma unroll
      for (int kk = 0; kk < 8; ++kk) {
        const bf16x8 kf = as_frag(*(const u32x4*)(km + (tok0 + 32 * st + r) * 512 + h * 128 + 16 * kk + 8 * hh));
        sacc = MFMA(kf, as_frag(qf[kk]), sacc);
      }
      const int tl = 32 * tt + r;
#pragma unroll
      for (int g4 = 0; g4 < 4; ++g4) {
        const float4 av = *(const float4*)(agv + 32 * st + 8 * g4 + 4 * hh);
        const float aa[4] = {av.x, av.y, av.z, av.w};
#pragma unroll
        for (int q = 0; q < 4; ++q) {
          const int s = 32 * st + 8 * g4 + 4 * hh + q;
          const float wgt = (s <= tl) ? sacc[4 * g4 + q] * __expf(cum_t + aa[q]) : 0.f;
          sacc[4 * g4 + q] = wgt;
          den_i += wgt;
        }
      }
#pragma unroll
      for (int ss = 0; ss < 2; ++ss) {
        u32x4 pk = {pack2(sacc[8 * ss], sacc[8 * ss + 1]), pack2(sacc[8 * ss + 2], sacc[8 * ss + 3]),
                    pack2(sacc[8 * ss + 4], sacc[8 * ss + 5]), pack2(sacc[8 * ss + 6], sacc[8 * ss + 7])};
        const bf16x8 pf = as_frag(pk);
#pragma unroll
        for (int vt = 0; vt < 4; ++vt) {
          const bfu* vp = vm + ((size_t)(bh * 64 + c) * 128 + vt * 32 + r) * 64 + 32 * st + 16 * ss + 4 * hh;
          const u32x2 lo = *(const u32x2*)vp;
          const u32x2 hi = *(const u32x2*)(vp + 8);
          u32x4 vv = {lo[0], lo[1], hi[0], hi[1]};
          ai[vt] = MFMA(as_frag(vv), pf, ai[vt]);
        }
      }
    }
    den_i += __shfl_xor(den_i, 32);
    const float den = den_i + e_t * dn;
    const float inv = 1.f / fmaxf(fabsf(den), 1.f);
    float s1 = 0.f;
#pragma unroll
    for (int vt = 0; vt < 4; ++vt)
#pragma unroll
      for (int i = 0; i < 16; ++i) {
        const float hv = ai[vt][i] * inv;
        ai[vt][i] = hv;
        s1 += hv;
      }
    s1 += __shfl_xor(s1, 32);
    const float mean = s1 * (1.f / 128.f);
    float s2 = 0.f;
#pragma unroll
    for (int vt = 0; vt < 4; ++vt)
#pragma unroll
      for (int i = 0; i < 16; ++i) { const float d = ai[vt][i] - mean; s2 += d * d; }
    s2 += __shfl_xor(s2, 32);
    const float rstd = rsqrtf(s2 * (1.f / 128.f) + 1e-5f);
#pragma unroll
    for (int vt = 0; vt < 4; ++vt) {
      u32x2 ob[4], xvp[4], zvp[4];
#pragma unroll
      for (int gp = 0; gp < 2; ++gp) {
        load_pair16(xcb + token * 512 + h * 128 + 32 * vt + 16 * gp, hh, xvp[2 * gp], xvp[2 * gp + 1]);
        load_pair16(proj + token * 3072 + 2560 + h * 128 + 32 * vt + 16 * gp, hh, zvp[2 * gp], zvp[2 * gp + 1]);
      }
#pragma unroll
      for (int g4 = 0; g4 < 4; ++g4) {
        const int v = 32 * vt + 8 * g4 + 4 * hh;
        const float4 og = *(const float4*)(p.out_g + h * 128 + v);
        const float4 sk = *(const float4*)(p.skip + h * 128 + v);
        const u32x2 xv = xvp[g4];
        const u32x2 zv = zvp[g4];
        const float y0 = ((ai[vt][4 * g4] - mean) * rstd * og.x + sk.x * bflo(xv[0])) * bflo(zv[0]);
        const float y1 = ((ai[vt][4 * g4 + 1] - mean) * rstd * og.y + sk.y * bfhi(xv[0])) * bfhi(zv[0]);
        const float y2 = ((ai[vt][4 * g4 + 2] - mean) * rstd * og.z + sk.z * bflo(xv[1])) * bflo(zv[1]);
        const float y3 = ((ai[vt][4 * g4 + 3] - mean) * rstd * og.w + sk.w * bfhi(xv[1])) * bfhi(zv[1]);
        ob[g4][0] = pack2(y0, y1); ob[g4][1] = pack2(y2, y3);
      }
      store_pair16(ym + token * 1024 + 512 + h * 128 + 32 * vt, ob[0], ob[1], hh);
      store_pair16(ym + token * 1024 + 512 + h * 128 + 32 * vt + 16, ob[2], ob[3], hh);
    }
  }
}

DI void sgu_item(const Params& p, int it, char* smem) {
  const int tid = tid_l(), lane = tid & 63, w = tid >> 6, r = lane & 31, hh = lane >> 5;
  const int g = it & 7, n = (it >> 3) & 31, b = it >> 8;
  const size_t tok0 = (size_t)b * 4096 + n * 128;
  float* sMu = (float*)smem;
  float* sRs = sMu + 128;
  if (tid < 128) {
    const float* st = (const float*)(p.ws + OFF_STATS) + (tok0 + tid) * 32;
    float s1 = 0.f, s2 = 0.f;
#pragma unroll
    for (int q = 0; q < 16; ++q) { s1 += st[2 * q]; s2 += st[2 * q + 1]; }
    const float mean = s1 * (1.f / 1024.f);
    const float var = fmaxf(s2 * (1.f / 1024.f) - mean * mean, 0.f);
    sMu[tid] = mean;
    sRs[tid] = rsqrtf(var + 1e-5f);
  }
  __syncthreads();
  const int cch = g * 128 + w * 32 + r;
  const float lng = p.c_ln_g[cch], lnb = p.c_ln_b[cch];
  const bfu* gvt = (const bfu*)(p.ws + OFF_GVT) + ((size_t)b * 1024 + cch) * 4096 + n * 128;
  const bfu* wsb = (const bfu*)(p.ws + OFF_WSB) + (size_t)g * 128 * 128;
  const bfu* proj = (const bfu*)(p.ws + OFF_PROJ);
  f32x16 acc[4];
#pragma unroll
  for (int tt = 0; tt < 4; ++tt)
#pragma unroll
    for (int i = 0; i < 16; ++i) acc[tt][i] = 0.f;
#pragma unroll
  for (int ks = 0; ks < 8; ++ks) {
    const u32x4 raw = *(const u32x4*)(gvt + 16 * ks + 8 * hh);
    float f[8];
#pragma unroll
    for (int q = 0; q < 4; ++q) { f[2 * q] = bflo(raw[q]); f[2 * q + 1] = bfhi(raw[q]); }
#pragma unroll
    for (int j = 0; j < 8; ++j) {
      const int s = 16 * ks + 8 * hh + j;
      f[j] = (f[j] - sMu[s]) * sRs[s] * lng + lnb;
    }
    u32x4 pk = {pack2(f[0], f[1]), pack2(f[2], f[3]), pack2(f[4], f[5]), pack2(f[6], f[7])};
    const bf16x8 af = as_frag(pk);
#pragma unroll
    for (int tt = 0; tt < 4; ++tt) {
      if (32 * tt + 31 >= 16 * ks) {
        const bf16x8 bfr = as_frag(*(const u32x4*)(wsb + (size_t)(32 * tt + r) * 128 + 16 * ks + 8 * hh));
        acc[tt] = MFMA(af, bfr, acc[tt]);
      }
    }
  }
  bfu* ym = (bfu*)(p.ws + OFF_HBUF);
#pragma unroll
  for (int tt = 0; tt < 4; ++tt) {
    const int t = 32 * tt + r;
    const size_t token = tok0 + t;
    const float bsv = p.c_bs[g * 128 + t];
    u32x2 ob[4], uvp[4], zvp[4];
#pragma unroll
    for (int gp = 0; gp < 2; ++gp) {
      load_pair16(proj + token * 3072 + g * 128 + w * 32 + 16 * gp, hh, uvp[2 * gp], uvp[2 * gp + 1]);
      load_pair16(proj + token * 3072 + 2048 + g * 128 + w * 32 + 16 * gp, hh, zvp[2 * gp], zvp[2 * gp + 1]);
    }
#pragma unroll
    for (int g4 = 0; g4 < 4; ++g4) {
      const u32x2 uv = uvp[g4];
      const u32x2 zv = zvp[g4];
      const float y0 = bflo(uv[0]) * (acc[tt][4 * g4] + bsv) * bflo(zv[0]);
      const float y1 = bfhi(uv[0]) * (acc[tt][4 * g4 + 1] + bsv) * bfhi(zv[0]);
      const float y2 = bflo(uv[1]) * (acc[tt][4 * g4 + 2] + bsv) * bflo(zv[1]);
      const float y3 = bfhi(uv[1]) * (acc[tt][4 * g4 + 3] + bsv) * bfhi(zv[1]);
      ob[g4][0] = pack2(y0, y1); ob[g4][1] = pack2(y2, y3);
    }
    store_pair16(ym + token * 1024 + g * 128 + w * 32, ob[0], ob[1], hh);
    store_pair16(ym + token * 1024 + g * 128 + w * 32 + 16, ob[2], ob[3], hh);
  }
  __syncthreads();
}

#ifndef ONLY_PH
#define ONLY_PH -1
#endif
#define PH_ON(x) (ONLY_PH < 0 || ONLY_PH == (x))
template <int ph>
DI void run_phase(const Params& pin, char* smem, bool rep) {
  const int G = gridDim.x, bid = blockIdx.x;
  if (!PH_ON(ph)) return;
  const Params& p = pin;
  switch (ph) {
    case 0: if (PH_ON(0)) {
      for (int it = bid; it < 1156; it += G) {
        if (it < 384) mod_item(p, it, (float*)smem);
        else if (it < 1152) { const int t = it - 384; transpose_tile(p.w_in, (bfu*)(p.ws + OFF_WTIN), 1024, 3072, (t & 15) * 64, (t >> 4) * 64, (float*)smem); }
        else gt_item(p, it - 1152);
      }
    } break;
    case 1: if (PH_ON(1))
      for (int it = bid; it < 512 + 96; it += G) { if (it < 512) norm_item(p, p.x, 0, it, (float*)smem); else modfin_item(p, it - 512); }
      break;
    case 2: if (PH_ON(2))
      if ((G & 7) == 0) {
        const int x = bid & 7;
        for (int lt = bid >> 3; lt < 192; lt += G >> 3)
          gemm_tile<0>(p, (const bfu*)(p.ws + OFF_HBUF), (const bfu*)(p.ws + OFF_WTIN), (x * 8 + lt / 24) * 256, (lt % 24) * 128, smem, 0, nullptr);
      } else {
        for (int t = bid; t < 64 * 24; t += G)
          gemm_tile<0>(p, (const bfu*)(p.ws + OFF_HBUF), (const bfu*)(p.ws + OFF_WTIN), (t / 24) * 256, (t % 24) * 128, smem, 0, nullptr);
      }
      break;
    case 3: if (PH_ON(3)) {
      const bool split = (G >= 512);
      for (int it = bid; it < 1600; it += (split ? (bid < 256 ? 1600 : G - 256) : G)) {
        if (it < 256) mlstm_prep_item(p, it, smem);
        else if (it < 1024) { const int t = it - 256; transpose_tile(p.w_in + (size_t)1024 * 3072, (bfu*)(p.ws + OFF_WTIN), 1024, 3072, (t & 15) * 64, (t >> 4) * 64, (float*)smem); }
        else if (it < 1280) { const int t = it - 1024; transpose_tile(p.w_out, (bfu*)(p.ws + OFF_WTOUT0), 1024, 1024, (t & 15) * 64, (t >> 4) * 64, (float*)smem); }
        else if (it < 1536) { const int t = it - 1280; transpose_tile(p.w_out + 1024 * 1024, (bfu*)(p.ws + OFF_WTOUT1), 1024, 1024, (t & 15) * 64, (t >> 4) * 64, (float*)smem); }
        else wsb_item(p, it - 1536);
      }
    } break;
    case 4: if (PH_ON(4)) {
      for (int it = bid; it < 129; it += G) { if (!rep) scan_item(p, it); }
      if ((G & 7) == 0) {
        const int x = bid & 7, nl = G >> 3, local = bid >> 3;
        for (int rd = 0; rd * nl < 128; ++rd) {
          const int li = (rd & 1) ? (rd + 1) * nl - 1 - local : rd * nl + local;
          if (li >= 128 || li < 0) continue;
          const int jj = li >> 3, rem = li & 7;
          moba_item(p, (jj << 6) | ((rem >> 2) << 5) | (x * 4 + (rem & 3)), smem);
        }
      } else {
        for (int rd = 0; rd * G < 1024; ++rd) {
          const int pos = (rd & 1) ? (rd + 1) * G - 1 - bid : rd * G + bid;
          if (pos >= 1024) continue;
          moba_item(p, pos, smem);
        }
      }
    } break;
    case 5: if (PH_ON(5)) {
      const int gw = __builtin_amdgcn_readfirstlane(bid * 4 + (tid_l() >> 6));
      for (int it = gw; it < 2048; it += G * 4) mlstm_out_item(p, it);
    } break;
    case 6: if (PH_ON(6))
      if ((G & 7) == 0) {
        const int x = bid & 7;
        for (int lt = bid >> 3; lt < 64; lt += G >> 3)
          gemm_tile<1>(p, (const bfu*)(p.ws + OFF_HBUF), (const bfu*)(p.ws + OFF_WTOUT0), (x * 8 + lt / 8) * 256, (lt % 8) * 128, smem, 0, p.x);
      } else {
        for (int t = bid; t < 64 * 8; t += G)
          gemm_tile<1>(p, (const bfu*)(p.ws + OFF_HBUF), (const bfu*)(p.ws + OFF_WTOUT0), (t / 8) * 256, (t % 8) * 128, smem, 0, p.x);
      }
      break;
    case 7: if (PH_ON(7))
      for (int it = bid; it < 512; it += G) norm_item(p, p.out, 1, it, (float*)smem);
      break;
    case 8: if (PH_ON(8))
      if ((G & 7) == 0) {
        const int x = bid & 7;
        for (int lt = bid >> 3; lt < 192; lt += G >> 3)
          gemm_tile<2>(p, (const bfu*)(p.ws + OFF_HBUF), (const bfu*)(p.ws + OFF_WTIN), (x * 8 + lt / 24) * 256, (lt % 24) * 128, smem, 1, nullptr);
      } else {
        for (int t = bid; t < 64 * 24; t += G)
          gemm_tile<2>(p, (const bfu*)(p.ws + OFF_HBUF), (const bfu*)(p.ws + OFF_WTIN), (t / 24) * 256, (t % 24) * 128, smem, 1, nullptr);
      }
      break;
    case 9: if (PH_ON(9))
      for (int it = bid; it < 1024; it += G) sgu_item(p, it, smem);
      break;
    case 10: if (PH_ON(10))
      if ((G & 7) == 0) {
        const int x = bid & 7;
        for (int lt = bid >> 3; lt < 64; lt += G >> 3)
          gemm_tile<1>(p, (const bfu*)(p.ws + OFF_HBUF), (const bfu*)(p.ws + OFF_WTOUT1), (x * 8 + lt / 8) * 256, (lt % 8) * 128, smem, 1, p.out);
      } else {
        for (int t = bid; t < 64 * 8; t += G)
          gemm_tile<1>(p, (const bfu*)(p.ws + OFF_HBUF), (const bfu*)(p.ws + OFF_WTOUT1), (t / 8) * 256, (t % 8) * 128, smem, 1, p.out);
      }
      break;
    default: break;
  }
}


#define XB_TMO      128
#define XB_XCNT(j)  (256  + 64 * (j))
#define XB_XSUB(j)  (1280 + 64 * (j))
#define XB_XGEN(j)  (2304 + 64 * (j))
#define XB_TOP      3328
#define XB_TOPGEN   3392
#define XCD_BAR_WORDS 3456
#define XB_SPIN_CAP (1u << 18)
#define LAS __attribute__((address_space(3)))

__device__ __forceinline__ unsigned xb_ld(unsigned* p)              { return __hip_atomic_load(p, __ATOMIC_RELAXED, __HIP_MEMORY_SCOPE_AGENT); }
__device__ __forceinline__ unsigned xb_add(unsigned* p, unsigned v) { return __hip_atomic_fetch_add(p, v, __ATOMIC_RELAXED, __HIP_MEMORY_SCOPE_AGENT); }
__device__ __forceinline__ unsigned xb_xcc_id() { return (unsigned)__builtin_amdgcn_s_getreg((3 << 11) | 20) & 0xFu; }
#define XB_SPIN(cond, bar) do { unsigned _sp = 0; while (cond) { __builtin_amdgcn_s_sleep(1); \
    if ((++_sp & 255u) == 0u) { if (xb_ld(&(bar)[XB_TMO])) break; if (_sp > XB_SPIN_CAP) { atomicAdd(&(bar)[XB_TMO], 1u); break; } } } } while (0)

struct XcdBarrier {
    unsigned* bar; unsigned x;
    volatile LAS unsigned* st;
};

__device__ __forceinline__ XcdBarrier xcd_barrier_post(unsigned* bar, volatile LAS unsigned* st) {
    XcdBarrier b; b.bar = bar; b.x = xb_xcc_id(); b.st = st;
    if (threadIdx.x == 0) (void)xb_add(&bar[XB_XCNT(b.x)], 1u);
    return b;
}
__device__ __forceinline__ void xcd_barrier_complete(unsigned* bar, unsigned x, unsigned& nloc, unsigned& nx) {
    const unsigned G = gridDim.x * gridDim.y * gridDim.z;
    unsigned sum, cnt, mine, sp = 0u;
    for (;;) {
        sum = 0u; cnt = 0u; mine = 0u;
#pragma unroll
        for (unsigned j = 0; j < 16; ++j) { const unsigned c = xb_ld(&bar[XB_XCNT(j)]); sum += c; cnt += (c > 0u) ? 1u : 0u; mine = (j == x) ? c : mine; }
        if (sum == G) break;
        __builtin_amdgcn_s_sleep(1);
        if ((++sp & 255u) == 0u) { if (xb_ld(&bar[XB_TMO])) break; if (sp > XB_SPIN_CAP) { atomicAdd(&bar[XB_TMO], 1u); break; } }
    }
    nloc = mine > 0u ? mine : 1u; nx = cnt > 0u ? cnt : 1u;
}

__device__ __forceinline__ void xcd_barrier(const XcdBarrier& b) {
    asm volatile("s_waitcnt vmcnt(0)" ::: "memory");
    __syncthreads();
    if (threadIdx.x == 0) {
        unsigned* bar = b.bar;
        __builtin_amdgcn_s_waitcnt(0);
        unsigned nloc = b.st[0], nx = b.st[1];
        if (nloc == 0u) { xcd_barrier_complete(bar, b.x, nloc, nx); b.st[0] = nloc; b.st[1] = nx; }
        const unsigned old = xb_add(&bar[XB_XSUB(b.x)], 1u);
        const unsigned gen = old / nloc;
        if (old + 1u == (gen + 1u) * nloc) {
            __builtin_amdgcn_fence(__ATOMIC_RELEASE, "agent");
            asm volatile("s_waitcnt vmcnt(0)" ::: "memory");
            const unsigned og = xb_add(&bar[XB_TOP], 1u);
            const unsigned tg = og / nx;
            if (og + 1u == (tg + 1u) * nx) xb_add(&bar[XB_TOPGEN], 1u);
            else XB_SPIN(xb_ld(&bar[XB_TOPGEN]) == tg, bar);
            __builtin_amdgcn_fence(__ATOMIC_ACQUIRE, "agent");
            xb_add(&bar[XB_XGEN(b.x)], 1u);
            asm volatile("s_waitcnt vmcnt(0)" ::: "memory");
        } else {
            XB_SPIN(xb_ld(&bar[XB_XGEN(b.x)]) == gen, bar);
            __builtin_amdgcn_fence(__ATOMIC_ACQUIRE, "agent");
            asm volatile("s_waitcnt vmcnt(0)" ::: "memory");
        }
    }
    __syncthreads();
}


constexpr int NPHASE = 11;

__global__ void __launch_bounds__(256, 2) fwd_mega(Params p, int never) {
  __shared__ __attribute__((aligned(16))) char smem[65536];
  cg::grid_group grid = cg::this_grid();
  if (never < 0) grid.sync();
  __shared__ uint4 xb_words;
  if (threadIdx.x == 0) xb_words = make_uint4(0u, 0u, 0u, 0u);
  __syncthreads();
  XcdBarrier xb = xcd_barrier_post((unsigned*)(p.ws + OFF_BAR), (volatile LAS unsigned*)&xb_words);
#ifndef REP_PH
#define REP_PH -1
#endif
#define PHASE(n)                                                      \
  run_phase<n>(p, smem, false);                                       \
  if (REP_PH == n) { xcd_barrier(xb); run_phase<n>(p, smem, true); }  \
  if (n + 1 < NPHASE) xcd_barrier(xb);
  PHASE(0) PHASE(1) PHASE(2) PHASE(3) PHASE(4) PHASE(5) PHASE(6) PHASE(7) PHASE(8) PHASE(9) PHASE(10)
}

extern "C" void kernel_launch(void* const* d_in, const int* in_sizes, int n_in, void* d_out, int out_size, void* d_ws,
                              size_t ws_size, hipStream_t stream) {
  Params p{};
  p.x = (const float*)d_in[0]; p.c = (const float*)d_in[1]; p.ln_g = (const float*)d_in[2];
  p.ada_w = (const float*)d_in[3]; p.ada_b = (const float*)d_in[4]; p.w_in = (const float*)d_in[5];
  p.w_out = (const float*)d_in[6]; p.a_q_g = (const float*)d_in[7]; p.a_k_g = (const float*)d_in[8];
  p.conv_w = (const float*)d_in[9]; p.conv_b = (const float*)d_in[10]; p.wq = (const float*)d_in[11];
  p.wk = (const float*)d_in[12]; p.wv = (const float*)d_in[13]; p.w_gates = (const float*)d_in[14];
  p.b_gates = (const float*)d_in[15]; p.out_g = (const float*)d_in[16]; p.skip = (const float*)d_in[17];
  p.c_ln_g = (const float*)d_in[18]; p.c_ln_b = (const float*)d_in[19]; p.c_ws = (const float*)d_in[20];
  p.c_bs = (const float*)d_in[21];
  p.out = (float*)d_out;
  p.ws = (char*)d_ws;
  static int grid_blocks = 0;
  if (!grid_blocks) {
    int dev = 0, cus = 0, per_cu = 0;
    hipGetDevice(&dev);
    hipDeviceGetAttribute(&cus, hipDeviceAttributeMultiprocessorCount, dev);
    hipOccupancyMaxActiveBlocksPerMultiprocessor(&per_cu, fwd_mega, 256, 0);
    if (per_cu > 2) per_cu = 2;
    if (per_cu < 1) per_cu = 1;
    grid_blocks = cus * per_cu;
  }
  hipMemsetAsync((char*)d_ws + OFF_BAR, 0, XCD_BAR_WORDS * 4, stream);
  int never = 0;
  void* args[] = {&p, &never};
  hipError_t e = hipLaunchCooperativeKernel((void*)fwd_mega, dim3(grid_blocks), dim3(256), args, 0, stream);
  if (e != hipSuccess) fprintf(stderr, "cooperative launch failed: %s (grid %d)\n", hipGetErrorString(e), grid_blocks);
}
```

```cpp
#include <hip/hip_runtime.h>
#include <hip/hip_cooperative_groups.h>
#include <stdint.h>
#include <cstdio>
#include <type_traits>
namespace cg = cooperative_groups;
#define DI __device__ __forceinline__

#ifndef MK_FUSED
#define MK_FUSED 1
#endif

typedef unsigned short bfu;
typedef short bf16x8 __attribute__((ext_vector_type(8)));
typedef float f32x16 __attribute__((ext_vector_type(16)));
typedef float f32x2 __attribute__((ext_vector_type(2)));
typedef __bf16 bf16x2v __attribute__((ext_vector_type(2)));
typedef unsigned u32x4 __attribute__((ext_vector_type(4)));
typedef unsigned u32x2 __attribute__((ext_vector_type(2)));

#define MFMA(a, b, c) __builtin_amdgcn_mfma_f32_32x32x16_bf16((a), (b), (c), 0, 0, 0)

DI unsigned pack2(float a, float b) { f32x2 v = {a, b}; bf16x2v r = __builtin_convertvector(v, bf16x2v); return __builtin_bit_cast(unsigned, r); }
DI float bflo(unsigned u) { return __uint_as_float(u << 16); }
DI float bfhi(unsigned u) { return __uint_as_float(u & 0xffff0000u); }
DI bfu f2bf(float a) { return (bfu)(pack2(a, 0.f) & 0xffffu); }
DI float bf2f(bfu h) { return __uint_as_float(((unsigned)h) << 16); }
DI int tid_l() { int t = threadIdx.x; asm volatile("" : "+v"(t)); return t; }
DI int crow(int i, int hh) { return (i & 3) + 8 * (i >> 2) + 4 * hh; }
DI float silu_f(float x) { return x * __builtin_amdgcn_rcpf(1.f + __builtin_amdgcn_exp2f(-1.4426950408889634f * x)); }
DI float gelu_f(float x) {
  const float u2 = 2.3022081981443144f * (x + 0.044715f * x * x * x);
  return x * __builtin_amdgcn_rcpf(1.f + __builtin_amdgcn_exp2f(-u2));
}
DI bf16x8 as_frag(u32x4 v) { return __builtin_bit_cast(bf16x8, v); }
DI void load_pair16(const bfu* p0, int hh, u32x2& a, u32x2& b) {
  const u32x4 l = *(const u32x4*)(p0 + 8 * hh);
  const auto s0 = __builtin_amdgcn_permlane32_swap(l[0], l[2], false, false);
  const auto s1 = __builtin_amdgcn_permlane32_swap(l[1], l[3], false, false);
  a[0] = s0[0]; a[1] = s1[0]; b[0] = s0[1]; b[1] = s1[1];
}
DI void store_pair16(bfu* p0, u32x2 a, u32x2 b, int hh) {
  const auto s0 = __builtin_amdgcn_permlane32_swap(a[0], b[0], false, false);
  const auto s1 = __builtin_amdgcn_permlane32_swap(a[1], b[1], false, false);
  u32x4 o = {s0[0], s1[0], s0[1], s1[1]};
  *(u32x4*)(p0 + 8 * hh) = o;
}

constexpr int NB = 4, SEQ = 4096, DM = 1024, NTOK = NB * SEQ;

constexpr size_t OFF_WTIN   = 0;
constexpr size_t OFF_WTOUT0 = OFF_WTIN + 6291456;
constexpr size_t OFF_WTOUT1 = OFF_WTOUT0 + 2097152;
constexpr size_t OFF_WSB    = OFF_WTOUT1 + 2097152;
constexpr size_t OFF_GT     = OFF_WSB + 262144;
constexpr size_t OFF_MODP   = OFF_GT + 65536;
constexpr size_t OFF_KSUM   = OFF_MODP + 1572864;
constexpr size_t OFF_CUM    = OFF_KSUM + 524288;
constexpr size_t OFF_AG     = OFF_CUM + 262144;
constexpr size_t OFF_TOT    = OFF_AG + 262144;
constexpr size_t OFF_HBUF   = OFF_TOT + 4096;
constexpr size_t OFF_PROJ   = OFF_HBUF + 33554432;
constexpr size_t OFF_MIX    = OFF_PROJ + 100663296;
constexpr size_t OFF_VT     = OFF_MIX;
constexpr size_t OFF_QM     = OFF_MIX + 16777216;
constexpr size_t OFF_KM     = OFF_QM + 16777216;
constexpr size_t OFF_VM     = OFF_KM + 16777216;
constexpr size_t OFF_XC     = OFF_VM + 16777216;
constexpr size_t OFF_UST    = OFF_XC + 16777216;
constexpr size_t OFF_END    = OFF_UST + 33816576;
constexpr size_t OFF_KT     = OFF_HBUF;
constexpr size_t OFF_GVT    = OFF_MIX;
constexpr size_t OFF_STATS  = OFF_MIX + 33554432;
constexpr size_t OFF_X1B    = OFF_MIX + 37748736;
constexpr size_t OFF_MODF   = OFF_END;
constexpr size_t OFF_BAR    = OFF_MODF + 98304;
static_assert(OFF_BAR + 16384 <= 268435456ull, "workspace overflow");

struct Params {
  const float *x, *c, *ln_g, *ada_w, *ada_b, *w_in, *w_out, *a_q_g, *a_k_g, *conv_w, *conv_b, *wq, *wk, *wv,
      *w_gates, *b_gates, *out_g, *skip, *c_ln_g, *c_ln_b, *c_ws, *c_bs;
  float* out;
  char* ws;
};

DI void transpose_tile(const float* __restrict__ src, bfu* __restrict__ dst, int K, int N, int k0, int n0, float* st) {
  const int tid = tid_l();
#pragma unroll
  for (int i = 0; i < 4; ++i) {
    const int r = (tid >> 4) + 16 * i, c4 = tid & 15;
    const float4 v = *(const float4*)(src + (size_t)(k0 + r) * N + n0 + 4 * c4);
    float* d = st + r * 65 + 4 * c4;
    d[0] = v.x; d[1] = v.y; d[2] = v.z; d[3] = v.w;
  }
  __syncthreads();
#pragma unroll
  for (int i = 0; i < 2; ++i) {
    const int n = (tid >> 3) + 32 * i, kc = tid & 7;
    float f[8];
#pragma unroll
    for (int j = 0; j < 8; ++j) f[j] = st[(8 * kc + j) * 65 + n];
    u32x4 o = {pack2(f[0], f[1]), pack2(f[2], f[3]), pack2(f[4], f[5]), pack2(f[6], f[7])};
    *(u32x4*)(dst + (size_t)(n0 + n) * K + k0 + 8 * kc) = o;
  }
  __syncthreads();
}

DI void mod_item(const Params& p, int it, float* sm) {
  const int layer = it / 192, rem = it % 192, cgp = rem >> 4, ks = rem & 15;
  const int tid = tid_l();
  {
    const int b = tid >> 6, kk = tid & 63;
    const float cv = p.c[b * 1024 + ks * 64 + kk];
    sm[tid] = silu_f(cv);
  }
  __syncthreads();
  const int col = cgp * 256 + tid;
  const float* w = p.ada_w + (size_t)layer * 1024 * 3072 + (size_t)(ks * 64) * 3072 + col;
  float a0 = 0.f, a1 = 0.f, a2 = 0.f, a3 = 0.f;
#pragma unroll 16
  for (int kk = 0; kk < 64; ++kk) {
    const float wv = w[(size_t)kk * 3072];
    a0 += sm[kk] * wv; a1 += sm[64 + kk] * wv; a2 += sm[128 + kk] * wv; a3 += sm[192 + kk] * wv;
  }
  float* o = (float*)(p.ws + OFF_MODP) + (size_t)((layer * 16 + ks) * 4) * 3072 + col;
  o[0] = a0; o[3072] = a1; o[2 * 3072] = a2; o[3 * 3072] = a3;
  __syncthreads();
}

DI void gt_item(const Params& p, int it) {
  const int ch = it * 256 + tid_l();
  bfu* gt = (bfu*)(p.ws + OFF_GT);
  for (int n = 0; n < 8; ++n) {
    float val = 0.f;
    if (ch < 512) {
      const int g = ch >> 2, ii = ch & 3;
      for (int o = 0; o < 4; ++o) {
        val += p.wq[g * 16 + ii * 4 + o] * p.w_gates[(4 * g + o) * 8 + n];
        val += p.wk[g * 16 + ii * 4 + o] * p.w_gates[(512 + 4 * g + o) * 8 + n];
      }
    } else {
      const int c2 = ch - 512, g = c2 >> 2, ii = c2 & 3;
      for (int o = 0; o < 4; ++o) val += p.wv[g * 16 + ii * 4 + o] * p.w_gates[(1024 + 4 * g + o) * 8 + n];
    }
    gt[n * 1024 + ch] = f2bf(val);
  }
  for (int n = 8; n < 32; ++n) gt[n * 1024 + ch] = 0;
}

DI void wsb_item(const Params& p, int it) {
  const int e = (it * 256 + tid_l()) * 8;
  const int t = (e >> 7) & 127, s0 = e & 127;
  float f[8];
#pragma unroll
  for (int j = 0; j < 8; ++j) f[j] = (s0 + j <= t) ? p.c_ws[e + j] : 0.f;
  u32x4 o = {pack2(f[0], f[1]), pack2(f[2], f[3]), pack2(f[4], f[5]), pack2(f[6], f[7])};
  *(u32x4*)((bfu*)(p.ws + OFF_WSB) + e) = o;
}

DI void norm_item(const Params& p, const float* __restrict__ xin, int layer, int it, float* sm) {
  float* sSc = sm;
  float* sSh = sm + 1024;
  const int tid = tid_l();
  const int row0 = it * 32;
  const int b = row0 >> 12;
  if (layer == 0) {
    const float* modp = (const float*)(p.ws + OFF_MODP);
#pragma unroll
    for (int cc = 0; cc < 4; ++cc) {
      const int col = tid + 256 * cc;
      float sc = p.ada_b[1024 + col], sh = p.ada_b[col];
#pragma unroll
      for (int ks = 0; ks < 16; ++ks) {
        const float* mp = modp + (size_t)(ks * 4 + b) * 3072;
        sc += mp[1024 + col];
        sh += mp[col];
      }
      sSc[col] = p.ln_g[col] * (1.f + sc);
      sSh[col] = sh;
    }
  } else {
    const float* mf = (const float*)(p.ws + OFF_MODF) + (size_t)(4 + b) * 3072;
#pragma unroll
    for (int cc = 0; cc < 4; ++cc) {
      const int col = tid + 256 * cc;
      sSc[col] = p.ln_g[1024 + col] * (1.f + mf[1024 + col]);
      sSh[col] = mf[col];
    }
  }
  __syncthreads();
  const int w = tid >> 6, lane = tid & 63;
  bfu* hb = (bfu*)(p.ws + OFF_HBUF);
#pragma unroll 1
  for (int rb = 0; rb < 2; ++rb) {
    const int rowb = row0 + w * 8 + rb * 4;
    float4 v[4][4];
    if (layer == 0) {
#pragma unroll
      for (int q = 0; q < 4; ++q)
#pragma unroll
        for (int j = 0; j < 4; ++j) v[q][j] = *(const float4*)(xin + (size_t)(rowb + q) * 1024 + lane * 4 + 256 * j);
    } else {
      const bfu* x1b = (const bfu*)(p.ws + OFF_X1B);
#pragma unroll
      for (int q = 0; q < 4; ++q)
#pragma unroll
        for (int j = 0; j < 4; ++j) {
          const u32x2 u = *(const u32x2*)(x1b + (size_t)(rowb + q) * 1024 + lane * 4 + 256 * j);
          v[q][j].x = bflo(u[0]); v[q][j].y = bfhi(u[0]); v[q][j].z = bflo(u[1]); v[q][j].w = bfhi(u[1]);
        }
    }
    float ss[4];
#pragma unroll
    for (int q = 0; q < 4; ++q) {
      float a = 0.f;
#pragma unroll
      for (int j = 0; j < 4; ++j) a += v[q][j].x * v[q][j].x + v[q][j].y * v[q][j].y + v[q][j].z * v[q][j].z + v[q][j].w * v[q][j].w;
      ss[q] = a;
    }
#pragma unroll
    for (int off = 32; off >= 1; off >>= 1)
#pragma unroll
      for (int q = 0; q < 4; ++q) ss[q] += __shfl_xor(ss[q], off);
#pragma unroll
    for (int q = 0; q < 4; ++q) {
      const float rstd = rsqrtf(ss[q] * (1.f / 1024.f) + 1e-6f);
#pragma unroll
      for (int j = 0; j < 4; ++j) {
        const int col = lane * 4 + 256 * j;
        const float4 sc4 = *(const float4*)(sSc + col);
        const float4 sh4 = *(const float4*)(sSh + col);
        const float y0 = v[q][j].x * rstd * sc4.x + sh4.x;
        const float y1 = v[q][j].y * rstd * sc4.y + sh4.y;
        const float y2 = v[q][j].z * rstd * sc4.z + sh4.z;
        const float y3 = v[q][j].w * rstd * sc4.w + sh4.w;
        u32x2 o = {pack2(y0, y1), pack2(y2, y3)};
        *(u32x2*)(hb + (size_t)(rowb + q) * 1024 + col) = o;
      }
    }
  }
  __syncthreads();
}

DI void modfin_item(const Params& p, int it) {
  const int idx = it * 256 + tid_l();
  const int layer = idx / 12288, rem = idx % 12288, b = rem / 3072, col = rem % 3072;
  const float* modp = (const float*)(p.ws + OFF_MODP);
  float a = p.ada_b[layer * 3072 + col];
#pragma unroll
  for (int ks = 0; ks < 16; ++ks) a += modp[(size_t)((layer * 16 + ks) * 4 + b) * 3072 + col];
  ((float*)(p.ws + OFF_MODF))[idx] = a;
}

#define GEMM_GL(KT)                                                                        \
  {                                                                                        \
    _Pragma("unroll") for (int i = 0; i < 8; ++i) ra[i] = *(const u32x4*)(ag + (size_t)i * 32 * K + (KT) * 64); \
    _Pragma("unroll") for (int i = 0; i < 4; ++i) rw[i] = *(const u32x4*)(wg + (size_t)i * 32 * K + (KT) * 64); \
  }
#define GEMM_LS()                                                                          \
  {                                                                                        \
    _Pragma("unroll") for (int i = 0; i < 8; ++i) *(u32x4*)(sA + ((EPI != 1) ? ldsa[i] : lds_w + i * 4096)) = ra[i]; \
    _Pragma("unroll") for (int i = 0; i < 4; ++i) *(u32x4*)(sW + lds_w + i * 4096) = rw[i]; \
  }
#define GEMM_COMPUTE()                                                                     \
  {                                                                                        \
    _Pragma("unroll") for (int kk = 0; kk < 4; ++kk) {                                     \
      bf16x8 fa[4], fw[2];                                                                 \
      const int sw = (((2 * kk + hh) ^ ((r >> 1) & 7)) << 4);                              \
      _Pragma("unroll") for (int mt = 0; mt < 4; ++mt)                                     \
        fa[mt] = *(const bf16x8*)(sA + (wm * 128 + mt * 32 + r) * 128 + sw);               \
      _Pragma("unroll") for (int nt = 0; nt < 2; ++nt)                                     \
        fw[nt] = *(const bf16x8*)(sW + (wn * 64 + nt * 32 + r) * 128 + sw);                \
      _Pragma("unroll") for (int nt = 0; nt < 2; ++nt)                                     \
        _Pragma("unroll") for (int mt = 0; mt < 4; ++mt)                                   \
          acc[nt][mt] = (EPI == 1) ? MFMA(fa[mt], fw[nt], acc[nt][mt]) : MFMA(fw[nt], fa[mt], acc[nt][mt]); \
    }                                                                                      \
  }

template <int EPI>
DI void gemm_tile(const Params& p, const bfu* __restrict__ A, const bfu* __restrict__ W, int m0, int n0, char* smem,
                  int layer, const float* __restrict__ resid) {
  constexpr int K = 1024;
  const int tid = tid_l(), lane = tid & 63, w = tid >> 6, r = lane & 31, hh = lane >> 5;
  const int wm = w & 1, wn = w >> 1;
  const int lrow = tid >> 3, lc = tid & 7;
  const bfu* ag = A + (size_t)(m0 + lrow) * K + lc * 8;
  const bfu* wg = W + (size_t)(n0 + lrow) * K + lc * 8;
  const int lds_w = lrow * 128 + ((lc ^ ((lrow >> 1) & 7)) << 4);
  int ldsa[8];
#pragma unroll
  for (int i = 0; i < 8; ++i) {
    const int prow = (i >> 2) * 128 + (2 * ((i & 3) >> 1) + (lrow & 1)) * 32 + (lrow >> 1) + 16 * (i & 1);
    ldsa[i] = prow * 128 + ((lc ^ ((prow >> 1) & 7)) << 4);
  }
#define GTOK(mt) (mw + 64 * ((mt) >> 1) + ((mt) & 1) + 2 * r)
  char* sA = smem;
  char* sW = smem + 32768;
  u32x4 ra[8], rw[4];
  GEMM_GL(0);
  float gate[2];
  if (EPI == 1) {
    const float* mf = (const float*)(p.ws + OFF_MODF) + (size_t)(layer * 4 + (m0 >> 12)) * 3072 + 2048 + n0 + wn * 64 + r;
    gate[0] = mf[0];
    gate[1] = mf[32];
  }
  f32x16 acc[2][4];
#pragma unroll
  for (int a = 0; a < 2; ++a)
#pragma unroll
    for (int b2 = 0; b2 < 4; ++b2)
#pragma unroll
      for (int i = 0; i < 16; ++i) acc[a][b2][i] = 0.f;
  GEMM_LS();
  __syncthreads();
#pragma unroll 1
  for (int kt = 0; kt < 16; ++kt) {
    const int kn = (kt + 1 < 16) ? kt + 1 : 15;
    GEMM_GL(kn);
    __builtin_amdgcn_sched_barrier(0);
    GEMM_COMPUTE();
    __syncthreads();
    GEMM_LS();
    __syncthreads();
  }

  const int nb = n0 + wn * 64;
  const int b = m0 >> 12;
  const int mw = m0 + wm * 128;
  bfu* proj = (bfu*)(p.ws + OFF_PROJ);
  if (EPI == 1) {
#pragma unroll
    for (int mt = 0; mt < 4; ++mt)
#pragma unroll
      for (int i = 0; i < 16; ++i) {
        const int token = mw + mt * 32 + crow(i, hh);
        const size_t off = (size_t)token * 1024 + nb + r;
        if (layer == 0) {
          const float r0 = resid[off], r1 = resid[off + 32];
          bfu* x1b = (bfu*)(p.ws + OFF_X1B);
          x1b[off] = f2bf(r0 + gate[0] * acc[0][mt][i]);
          x1b[off + 32] = f2bf(r1 + gate[1] * acc[1][mt][i]);
        } else {
          const bfu* x1b = (const bfu*)(p.ws + OFF_X1B);
          const float r0 = bf2f(x1b[off]), r1 = bf2f(x1b[off + 32]);
          __builtin_nontemporal_store(r0 + gate[0] * acc[0][mt][i], p.out + off);
          __builtin_nontemporal_store(r1 + gate[1] * acc[1][mt][i], p.out + off + 32);
        }
      }
  } else if (EPI == 0) {
    if (nb < 1024) {
      const bool isk = nb >= 512;
      const float* gg = isk ? p.a_k_g : p.a_q_g;
      float gv[2][16], cs[2][16];
#pragma unroll
      for (int nt = 0; nt < 2; ++nt)
#pragma unroll
        for (int i = 0; i < 16; ++i) { gv[nt][i] = gg[nt * 32 + crow(i, hh)]; cs[nt][i] = 0.f; }
#pragma unroll
      for (int mt = 0; mt < 4; ++mt) {
        float ss = 0.f;
#pragma unroll
        for (int nt = 0; nt < 2; ++nt)
#pragma unroll
          for (int i = 0; i < 16; ++i) ss += acc[nt][mt][i] * acc[nt][mt][i];
        ss += __shfl_xor(ss, 32);
        const float rstd = rsqrtf(ss * (1.f / 64.f) + 1e-6f);
        const int token = GTOK(mt);
        bfu* dst = proj + (size_t)token * 3072 + nb;
#pragma unroll
        for (int nt = 0; nt < 2; ++nt) {
          u32x2 ob[4];
#pragma unroll
          for (int g4 = 0; g4 < 4; ++g4) {
            float v[4];
#pragma unroll
            for (int q = 0; q < 4; ++q) {
              v[q] = acc[nt][mt][4 * g4 + q] * rstd * gv[nt][4 * g4 + q];
              cs[nt][4 * g4 + q] += v[q];
            }
            ob[g4][0] = pack2(v[0], v[1]); ob[g4][1] = pack2(v[2], v[3]);
          }
          store_pair16(dst + nt * 32, ob[0], ob[1], hh);
          store_pair16(dst + nt * 32 + 16, ob[2], ob[3], hh);
        }
      }
      if (isk) {
        const int head = (nb - 512) >> 6;
        const int tokblk = (mw & 4095) >> 7;
        float* ks = (float*)(p.ws + OFF_KSUM) + (size_t)((b * 8 + head) * 32 + tokblk) * 64;
#pragma unroll
        for (int nt = 0; nt < 2; ++nt)
#pragma unroll
          for (int i = 0; i < 16; ++i) {
            float v = cs[nt][i];
#pragma unroll
            for (int off = 1; off < 32; off <<= 1) v += __shfl_xor(v, off);
            if (r == 0) ks[nt * 32 + crow(i, hh)] = v;
          }
      }
    } else if (nb < 1536) {
      const int head = (nb - 1024) >> 6;
      bfu* vt = (bfu*)(p.ws + OFF_VT) + (size_t)((b * 8 + head) * 64) * 4096;
#pragma unroll
      for (int nt = 0; nt < 2; ++nt)
#pragma unroll
        for (int a = 0; a < 2; ++a) {
          const int s0 = (mw & 4095) + 64 * a + 2 * r;
#pragma unroll
          for (int i = 0; i < 16; ++i)
            *(unsigned*)(vt + (size_t)(nt * 32 + crow(i, hh)) * 4096 + s0) = pack2(acc[nt][2 * a][i], acc[nt][2 * a + 1][i]);
        }
    } else {
      const bool act = (nb < 2048) || (nb >= 2560);
#pragma unroll
      for (int nt = 0; nt < 2; ++nt)
#pragma unroll
        for (int mt = 0; mt < 4; ++mt) {
          const int token = GTOK(mt);
          bfu* dst = proj + (size_t)token * 3072 + nb + nt * 32;
          u32x2 ob[4];
#pragma unroll
          for (int g4 = 0; g4 < 4; ++g4) {
            float v[4];
#pragma unroll
            for (int q = 0; q < 4; ++q) { v[q] = acc[nt][mt][4 * g4 + q]; if (act) v[q] = silu_f(v[q]); }
            ob[g4][0] = pack2(v[0], v[1]); ob[g4][1] = pack2(v[2], v[3]);
          }
          store_pair16(dst, ob[0], ob[1], hh);
          store_pair16(dst + 16, ob[2], ob[3], hh);
        }
    }
  } else {
    if (nb >= 1024 && nb < 2048) {
      const int c0 = nb - 1024;
      bfu* gvt = (bfu*)(p.ws + OFF_GVT) + (size_t)(b * 1024 + c0) * 4096;
      float* stats = (float*)(p.ws + OFF_STATS);
#pragma unroll
      for (int mt = 0; mt < 4; ++mt) {
        const int token = GTOK(mt);
        float s1 = 0.f, s2 = 0.f;
#pragma unroll
        for (int nt = 0; nt < 2; ++nt)
#pragma unroll
          for (int i = 0; i < 16; ++i) {
            const float v = gelu_f(acc[nt][mt][i]);
            s1 += v; s2 += v * v;
            acc[nt][mt][i] = v;
          }
        s1 += __shfl_xor(s1, 32);
        s2 += __shfl_xor(s2, 32);
        if (hh == 0) {
          float2 o; o.x = s1; o.y = s2;
          *(float2*)(stats + ((size_t)token * 16 + (c0 >> 6)) * 2) = o;
        }
      }
#pragma unroll
      for (int nt = 0; nt < 2; ++nt)
#pragma unroll
        for (int a = 0; a < 2; ++a) {
          const int s0 = (mw & 4095) + 64 * a + 2 * r;
#pragma unroll
          for (int i = 0; i < 16; ++i)
            *(unsigned*)(gvt + (size_t)(nt * 32 + crow(i, hh)) * 4096 + s0) = pack2(acc[nt][2 * a][i], acc[nt][2 * a + 1][i]);
        }
    } else {
      const bool isu = nb < 1024;
#pragma unroll
      for (int nt = 0; nt < 2; ++nt)
#pragma unroll
        for (int mt = 0; mt < 4; ++mt) {
          const int token = GTOK(mt);
          bfu* dst = proj + (size_t)token * 3072 + nb + nt * 32;
          u32x2 ob[4];
#pragma unroll
          for (int g4 = 0; g4 < 4; ++g4) {
            float v[4];
#pragma unroll
            for (int q = 0; q < 4; ++q) { const float a = acc[nt][mt][4 * g4 + q]; v[q] = isu ? gelu_f(a) : silu_f(a); }
            ob[g4][0] = pack2(v[0], v[1]); ob[g4][1] = pack2(v[2], v[3]);
          }
          store_pair16(dst, ob[0], ob[1], hh);
          store_pair16(dst + 16, ob[2], ob[3], hh);
        }
    }
  }
}

#undef GTOK
DI void mlstm_prep_item(const Params& p, int it, char* smem) {
  const int tid = tid_l(), lane = tid & 63, w = __builtin_amdgcn_readfirstlane(tid >> 6), r = lane & 31, hh = lane >> 5;
  const int b = it >> 6, c = it & 63;
  const int tok0 = b * 4096 + c * 64;
  const bfu* proj = (const bfu*)(p.ws + OFF_PROJ);
  bfu* qm = (bfu*)(p.ws + OFF_QM);
  bfu* km = (bfu*)(p.ws + OFF_KM);
  bfu* vm = (bfu*)(p.ws + OFF_VM);
  bfu* xcb = (bfu*)(p.ws + OFF_XC);
  bfu* ktm = (bfu*)(p.ws + OFF_KT);
  float* sG = (float*)smem;
  float* sWt = (float*)(smem + 8192);
  {
    const int blk = tid & 127, th = tid >> 7;
    const int ch = blk * 4;
    float cw[4][4], cb[4], q_w[4][4], k_w[4][4], v_w[4][4];
#pragma unroll
    for (int j = 0; j < 4; ++j)
#pragma unroll
      for (int i = 0; i < 4; ++i) {
        cw[j][i] = p.conv_w[j * 512 + ch + i];
        q_w[j][i] = p.wq[blk * 16 + j * 4 + i];
        k_w[j][i] = p.wk[blk * 16 + j * 4 + i];
        v_w[j][i] = p.wv[blk * 16 + j * 4 + i];
      }
#pragma unroll
    for (int i = 0; i < 4; ++i) cb[i] = p.conv_b[ch + i];
    float win[4][4];
    const int sl0 = c * 64 + th * 32;
#pragma unroll
    for (int j = 0; j < 3; ++j) {
      const int sp = sl0 - 3 + j;
      if (sp >= 0) {
        const u32x2 v = *(const u32x2*)(proj + (size_t)(b * 4096 + sp) * 3072 + 2048 + ch);
        win[j][0] = bflo(v[0]); win[j][1] = bfhi(v[0]); win[j][2] = bflo(v[1]); win[j][3] = bfhi(v[1]);
      } else {
        win[j][0] = win[j][1] = win[j][2] = win[j][3] = 0.f;
      }
    }
    const float kscale = 0.08838834764831845f;
    const bfu* bxp = proj + ((size_t)b * 4096 + sl0) * 3072 + 2048 + ch;
    u32x2 cur[8], nxt[8];
    float kk8[4][8], vv8[4][8];
#pragma unroll
    for (int q = 0; q < 8; ++q) cur[q] = *(const u32x2*)(bxp + (size_t)q * 3072);
#pragma unroll 1
    for (int t8 = 0; t8 < 4; ++t8) {
      const int tn = (t8 < 3) ? (t8 + 1) * 8 : 24;
#pragma unroll
      for (int q = 0; q < 8; ++q) nxt[q] = *(const u32x2*)(bxp + (size_t)(tn + q) * 3072);
      __builtin_amdgcn_sched_barrier(0);
#pragma unroll
      for (int q = 0; q < 8; ++q) {
        const size_t token = (size_t)b * 4096 + sl0 + t8 * 8 + q;
        const u32x2 v = cur[q];
        win[3][0] = bflo(v[0]); win[3][1] = bfhi(v[0]); win[3][2] = bflo(v[1]); win[3][3] = bfhi(v[1]);
        float xc[4], bq[4], bk[4], bv[4];
#pragma unroll
        for (int i = 0; i < 4; ++i) {
          float a = cb[i];
#pragma unroll
          for (int j = 0; j < 4; ++j) a += cw[j][i] * win[j][i];
          xc[i] = silu_f(a);
        }
#pragma unroll
        for (int o = 0; o < 4; ++o) {
          float aq = 0.f, ak = 0.f, av = 0.f;
#pragma unroll
          for (int i = 0; i < 4; ++i) { aq += xc[i] * q_w[i][o]; ak += xc[i] * k_w[i][o]; av += win[3][i] * v_w[i][o]; }
          bq[o] = aq; bk[o] = ak * kscale; bv[o] = av;
        }
        u32x2 o;
        o[0] = pack2(bq[0], bq[1]); o[1] = pack2(bq[2], bq[3]); *(u32x2*)(qm + token * 512 + ch) = o;
        o[0] = pack2(bk[0], bk[1]); o[1] = pack2(bk[2], bk[3]); *(u32x2*)(km + token * 512 + ch) = o;
#pragma unroll
        for (int o4 = 0; o4 < 4; ++o4) { kk8[o4][q] = bk[o4]; vv8[o4][q] = bv[o4]; }
        o[0] = pack2(xc[0], xc[1]); o[1] = pack2(xc[2], xc[3]); *(u32x2*)(xcb + token * 512 + ch) = o;
#pragma unroll
        for (int j = 0; j < 3; ++j)
#pragma unroll
          for (int i = 0; i < 4; ++i) win[j][i] = win[j + 1][i];
      }
#pragma unroll
      for (int o4 = 0; o4 < 4; ++o4) {
        const size_t off = ((size_t)((b * 4 + (blk >> 5)) * 64 + c) * 128 + (blk & 31) * 4 + o4) * 64 + th * 32 + t8 * 8;
        u32x4 pk = {pack2(kk8[o4][0], kk8[o4][1]), pack2(kk8[o4][2], kk8[o4][3]), pack2(kk8[o4][4], kk8[o4][5]), pack2(kk8[o4][6], kk8[o4][7])};
        *(u32x4*)(ktm + off) = pk;
        u32x4 pv = {pack2(vv8[o4][0], vv8[o4][1]), pack2(vv8[o4][2], vv8[o4][3]), pack2(vv8[o4][4], vv8[o4][5]), pack2(vv8[o4][6], vv8[o4][7])};
        *(u32x4*)(vm + off) = pv;
      }
#pragma unroll
      for (int q = 0; q < 8; ++q) cur[q] = nxt[q];
    }
  }
  __threadfence_block();
  __syncthreads();
  {
    const bfu* gt = (const bfu*)(p.ws + OFF_GT);
    f32x16 acc[2];
#pragma unroll
    for (int tt = 0; tt < 2; ++tt)
#pragma unroll
      for (int i = 0; i < 16; ++i) acc[tt][i] = 0.f;
#pragma unroll 4
    for (int ksi = 0; ksi < 16; ++ksi) {
      const int ch = (16 * w + ksi) * 16 + 8 * hh;
      const bf16x8 af = as_frag(*(const u32x4*)(gt + r * 1024 + ch));
#pragma unroll
      for (int tt = 0; tt < 2; ++tt) {
        const size_t token = (size_t)tok0 + 32 * tt + r;
        const bfu* src = (ch < 512) ? (xcb + token * 512 + ch) : (proj + token * 3072 + 2048 + (ch - 512));
        const bf16x8 bfr = as_frag(*(const u32x4*)src);
        acc[tt] = MFMA(af, bfr, acc[tt]);
      }
    }
#pragma unroll
    for (int tt = 0; tt < 2; ++tt)
#pragma unroll
      for (int i = 0; i < 4; ++i) sG[(w * 8 + 4 * hh + i) * 64 + 32 * tt + r] = acc[tt][i];
  }
  __syncthreads();
  {
    const int head = w, tok = lane;
    float ig = p.b_gates[head], fg = p.b_gates[4 + head];
#pragma unroll
    for (int ww = 0; ww < 4; ++ww) { ig += sG[(ww * 8 + head) * 64 + tok]; fg += sG[(ww * 8 + 4 + head) * 64 + tok]; }
    const float lf = fminf(fg, 0.f) - log1pf(__expf(-fabsf(fg)));
    float cum = lf;
#pragma unroll
    for (int off = 1; off < 64; off <<= 1) {
      const float o = __shfl_up(cum, off);
      if (lane >= off) cum += o;
    }
    const float tot = __shfl(cum, 63);
    const float a = ig - cum;
    const int bh = b * 4 + head;
    ((float*)(p.ws + OFF_CUM))[(size_t)bh * 4096 + c * 64 + tok] = cum;
    ((float*)(p.ws + OFF_AG))[(size_t)bh * 4096 + c * 64 + tok] = a;
    if (lane == 0) ((float*)(p.ws + OFF_TOT))[bh * 64 + c] = tot;
    sWt[head * 64 + tok] = __expf(tot + a);
  }
  __syncthreads();
  {
    const int h = w;
    const int bh = b * 4 + h;
    const bfu* ktc = ktm + (size_t)(bh * 64 + c) * 128 * 64;
    const bfu* vtc = vm + (size_t)(bh * 64 + c) * 128 * 64;
    bfu* ust = (bfu*)(p.ws + OFF_UST) + (size_t)(bh * 64 + c) * 129 * 128;
    float wsr[4][8];
#pragma unroll
    for (int ss = 0; ss < 4; ++ss)
#pragma unroll
      for (int j = 0; j < 8; ++j) wsr[ss][j] = sWt[h * 64 + 16 * ss + 8 * hh + j];
    u32x4 vall[4][4];
#pragma unroll
    for (int vt = 0; vt < 4; ++vt)
#pragma unroll
      for (int ss = 0; ss < 4; ++ss) vall[vt][ss] = *(const u32x4*)(vtc + (size_t)(vt * 32 + r) * 64 + 16 * ss + 8 * hh);
    bf16x8 kall[4][4];
#pragma unroll
    for (int kt = 0; kt < 4; ++kt)
#pragma unroll
      for (int ss = 0; ss < 4; ++ss) kall[kt][ss] = as_frag(*(const u32x4*)(ktc + (size_t)(kt * 32 + r) * 64 + 16 * ss + 8 * hh));
#pragma unroll
    for (int vt = 0; vt < 5; ++vt) {
      bf16x8 vf[4];
#pragma unroll
      for (int ss = 0; ss < 4; ++ss) {
        float f[8];
        if (vt < 4) {
#pragma unroll
          for (int q = 0; q < 4; ++q) { f[2 * q] = bflo(vall[vt < 4 ? vt : 0][ss][q]) * wsr[ss][2 * q]; f[2 * q + 1] = bfhi(vall[vt < 4 ? vt : 0][ss][q]) * wsr[ss][2 * q + 1]; }
        } else {
#pragma unroll
          for (int j = 0; j < 8; ++j) f[j] = (r == 0) ? wsr[ss][j] : 0.f;
        }
        u32x4 pk = {pack2(f[0], f[1]), pack2(f[2], f[3]), pack2(f[4], f[5]), pack2(f[6], f[7])};
        vf[ss] = as_frag(pk);
      }
#pragma unroll
      for (int kp = 0; kp < 2; ++kp) {
        f32x16 acc[2];
#pragma unroll
        for (int kt = 0; kt < 2; ++kt)
#pragma unroll
          for (int i = 0; i < 16; ++i) acc[kt][i] = 0.f;
#pragma unroll
        for (int ss = 0; ss < 4; ++ss)
#pragma unroll
          for (int kt = 0; kt < 2; ++kt) acc[kt] = MFMA(kall[kp * 2 + kt][ss], vf[ss], acc[kt]);
#pragma unroll
        for (int kt = 0; kt < 2; ++kt)
#pragma unroll
          for (int gp = 0; gp < 2; ++gp) {
            u32x2 oa = {pack2(acc[kt][8 * gp], acc[kt][8 * gp + 1]), pack2(acc[kt][8 * gp + 2], acc[kt][8 * gp + 3])};
            u32x2 obb = {pack2(acc[kt][8 * gp + 4], acc[kt][8 * gp + 5]), pack2(acc[kt][8 * gp + 6], acc[kt][8 * gp + 7])};
            const auto s0 = __builtin_amdgcn_permlane32_swap(oa[0], obb[0], false, false);
            const auto s1 = __builtin_amdgcn_permlane32_swap(oa[1], obb[1], false, false);
            u32x4 o = {s0[0], s1[0], s0[1], s1[1]};
            if (vt < 4 || r == 0) *(u32x4*)(ust + (size_t)(vt * 32 + r) * 128 + (kp * 2 + kt) * 32 + 16 * gp + 8 * hh) = o;
          }
      }
    }
  }
  __syncthreads();
}

DI void scan_item(const Params& p, int it) {
  const int id = it * 256 + tid_l();
  const int bh = id / 2064, e8 = id % 2064;
  bfu* base = (bfu*)(p.ws + OFF_UST) + (size_t)bh * 64 * 16512 + e8 * 8;
  const float* tot = (const float*)(p.ws + OFF_TOT) + bh * 64;
  float st[8];
#pragma unroll
  for (int j = 0; j < 8; ++j) st[j] = 0.f;
  for (int c0 = 0; c0 < 64; c0 += 8) {
    u32x4 u[8];
#pragma unroll
    for (int j = 0; j < 8; ++j) u[j] = *(const u32x4*)(base + (size_t)(c0 + j) * 16512);
#pragma unroll
    for (int j = 0; j < 8; ++j) {
      u32x4 o = {pack2(st[0], st[1]), pack2(st[2], st[3]), pack2(st[4], st[5]), pack2(st[6], st[7])};
      *(u32x4*)(base + (size_t)(c0 + j) * 16512) = o;
      const float dec = __expf(tot[c0 + j]);
#pragma unroll
      for (int q = 0; q < 4; ++q) {
        st[2 * q] = dec * st[2 * q] + bflo(u[j][q]);
        st[2 * q + 1] = dec * st[2 * q + 1] + bfhi(u[j][q]);
      }
    }
  }
}

DI void moba_item(const Params& p, int mi, char* smem) {
  const int tid = tid_l(), lane = tid & 63, w = tid >> 6, r = lane & 31, hh = lane >> 5;
  const int jb = 15 - (mi >> 6);
  const int rem = mi & 63;
  const int half = 1 - (rem >> 5);
  const int bh = rem & 31;
  const int b = bh >> 3, h = bh & 7;
  const int q0 = jb * 256 + half * 128;
  const size_t tokbase = (size_t)b * 4096;
  const bfu* proj = (const bfu*)(p.ws + OFF_PROJ);
  const bfu* vtg = (const bfu*)(p.ws + OFF_VT) + (size_t)bh * 64 * 4096;
  float* sKM = (float*)smem;
  char* sK = smem + 4096;
  char* sV = smem + 4096 + 24576;
  {
    const float* ks = (const float*)(p.ws + OFF_KSUM) + (size_t)bh * 32 * 64;
    for (int idx = tid; idx < jb * 64; idx += 256) {
      const int n = idx >> 6, d = idx & 63;
      const float* q2 = ks + (size_t)(2 * n) * 64 + d;
      sKM[idx] = q2[0] + q2[64];
    }
  }
  const int qpos = q0 + w * 32 + r;
  const size_t qtoken = tokbase + qpos;
  u32x4 qf[4];
#pragma unroll
  for (int kk = 0; kk < 4; ++kk) qf[kk] = *(const u32x4*)(proj + qtoken * 3072 + h * 64 + kk * 16 + hh * 8);
  __syncthreads();
  unsigned sel;
  {
    float s1 = -INFINITY, s2 = -INFINITY, s3 = -INFINITY;
    int i1 = -1, i2 = -1, i3 = -1;
    for (int n = 0; n < jb; ++n) {
      float dot = 0.f;
#pragma unroll
      for (int kk = 0; kk < 4; ++kk) {
        const float* km = sKM + n * 64 + kk * 16 + hh * 8;
#pragma unroll
        for (int e = 0; e < 4; ++e) {
          dot += bflo(qf[kk][e]) * km[2 * e];
          dot += bfhi(qf[kk][e]) * km[2 * e + 1];
        }
      }
      dot += __shfl_xor(dot, 32);
      if (dot > s1) { s3 = s2; i3 = i2; s2 = s1; i2 = i1; s1 = dot; i1 = n; }
      else if (dot > s2) { s3 = s2; i3 = i2; s2 = dot; i2 = n; }
      else if (dot > s3) { s3 = dot; i3 = n; }
    }
    if (jb <= 3) sel = (1u << jb) - 1u;
    else sel = (1u << i1) | (1u << i2) | (1u << i3);
  }
  const int ntile = 4 * jb + (half ? 4 : 2);
  const int lrow = tid >> 3, lch = tid & 7;
  u32x4 kregA[2], vregA[2], kregB[2], vregB[2];
  auto gload = [&](int tix, u32x4 (&kreg)[2], u32x4 (&vreg)[2]) {
    const int n = tix >> 2, tk = tix & 3;
    const int key0 = n * 256 + tk * 64;
#pragma unroll
    for (int i = 0; i < 2; ++i) {
      const int row = lrow + 32 * i;
      kreg[i] = *(const u32x4*)(proj + (tokbase + key0 + row) * 3072 + 512 + h * 64 + lch * 8);
      vreg[i] = *(const u32x4*)(vtg + (size_t)row * 4096 + key0 + lch * 8);
    }
  };
  auto lstore = [&](int buf, u32x4 (&kreg)[2], u32x4 (&vreg)[2]) {
#pragma unroll
    for (int i = 0; i < 2; ++i) {
      const int row = lrow + 32 * i;
      const int sw = (row >> 1) & 7;
      *(u32x4*)(sK + buf * 8192 + row * 128 + ((lch ^ sw) << 4)) = kreg[i];
      const int g = lch >> 1, hf = (lch & 1) << 3;
      u32x2 lo = {vreg[i][0], vreg[i][1]}, hi = {vreg[i][2], vreg[i][3]};
      *(u32x2*)(sV + buf * 8192 + row * 128 + (((2 * g) ^ sw) << 4) + hf) = lo;
      *(u32x2*)(sV + buf * 8192 + row * 128 + (((2 * g + 1) ^ sw) << 4) + hf) = hi;
    }
  };
  const f32x16 zero16 = {0.f, 0.f, 0.f, 0.f, 0.f, 0.f, 0.f, 0.f, 0.f, 0.f, 0.f, 0.f, 0.f, 0.f, 0.f, 0.f};
  const int qmax = q0 + w * 32 + 31;
  int lofs[4];
#pragma unroll
  for (int g = 0; g < 4; ++g) lofs[g] = r * 128 + (((2 * g + hh) ^ ((r >> 1) & 7)) << 4);
  auto compute_s = [&](int tix, int buf, f32x16 (&s)[2]) {
    const int key0 = (tix >> 2) * 256 + (tix & 3) * 64;
    if (key0 <= qmax) {
      const char* kb = sK + buf * 8192;
      const bool two = (key0 + 32 <= qmax);
      if ((tix >> 2) == jb) {
        const int lim = qpos - key0 - 4 * hh;
        f32x16 b0, b1;
#pragma unroll
        for (int i = 0; i < 16; ++i) {
          const int cidx = (i & 3) + 8 * (i >> 2);
          b0[i] = (cidx <= lim) ? 0.f : -INFINITY;
          b1[i] = (two && (32 + cidx <= lim)) ? 0.f : -INFINITY;
        }
        s[0] = MFMA(*(const bf16x8*)(kb + lofs[0]), as_frag(qf[0]), b0);
#pragma unroll
        for (int kk = 1; kk < 4; ++kk) s[0] = MFMA(*(const bf16x8*)(kb + lofs[kk]), as_frag(qf[kk]), s[0]);
        if (two) {
          s[1] = MFMA(*(const bf16x8*)(kb + 4096 + lofs[0]), as_frag(qf[0]), b1);
#pragma unroll
          for (int kk = 1; kk < 4; ++kk) s[1] = MFMA(*(const bf16x8*)(kb + 4096 + lofs[kk]), as_frag(qf[kk]), s[1]);
        } else {
          s[1] = b1;
        }
      } else {
        s[0] = MFMA(*(const bf16x8*)(kb + lofs[0]), as_frag(qf[0]), zero16);
#pragma unroll
        for (int kk = 1; kk < 4; ++kk) s[0] = MFMA(*(const bf16x8*)(kb + lofs[kk]), as_frag(qf[kk]), s[0]);
        s[1] = MFMA(*(const bf16x8*)(kb + 4096 + lofs[0]), as_frag(qf[0]), zero16);
#pragma unroll
        for (int kk = 1; kk < 4; ++kk) s[1] = MFMA(*(const bf16x8*)(kb + 4096 + lofs[kk]), as_frag(qf[kk]), s[1]);
      }
    }
  };
  f32x16 oacc[2];
#pragma unroll
  for (int dt = 0; dt < 2; ++dt)
#pragma unroll
    for (int i = 0; i < 16; ++i) oacc[dt][i] = 0.f;
  float mrun = -1e30f;
  f32x16 lacc = zero16;
  const unsigned onev = (r == 0) ? 0x3F803F80u : 0u;
  const u32x4 ones4 = {onev, onev, onev, onev};
  const bf16x8 onesf = as_frag(ones4);
  const float cs = 0.125f * 1.4426950408889634f;
  auto step = [&](int tix, int b0, int b1, int b2, f32x16 (&scur)[2], f32x16 (&snext)[2], u32x4 (&kreg)[2], u32x4 (&vreg)[2]) {
    if (tix + 1 < ntile) compute_s(tix + 1, b1, snext);
    const int n = tix >> 2, tk = tix & 3;
    const int key0 = n * 256 + tk * 64;
    if (key0 <= qmax) {
      const char* vb = sV + b0 * 8192;
      const bool own = (n == jb);
      const bool lsel = own || ((sel >> n) & 1u);
      const bool act1 = (key0 + 32 <= qmax);
      float mt = scur[0][0];
#pragma unroll
      for (int i = 1; i < 16; ++i) mt = fmaxf(mt, scur[0][i]);
#pragma unroll
      for (int i = 0; i < 16; ++i) mt = fmaxf(mt, scur[1][i]);
      mt = fmaxf(mt, __shfl_xor(mt, 32));
      mt = lsel ? mt : -INFINITY;
      const float mnew = fmaxf(mrun, mt);
      const float alpha = __builtin_amdgcn_exp2f((mrun - mnew) * cs);
      mrun = mnew;
      const float nbias = (lsel && mnew > -1e29f) ? -mnew * cs : -INFINITY;
#pragma unroll
      for (int kt = 0; kt < 2; ++kt)
#pragma unroll
        for (int i = 0; i < 16; ++i) scur[kt][i] = __builtin_amdgcn_exp2f(__builtin_fmaf(scur[kt][i], cs, nbias));
      lacc[0] *= alpha;
#pragma unroll
      for (int dt = 0; dt < 2; ++dt)
#pragma unroll
        for (int i = 0; i < 16; ++i) oacc[dt][i] *= alpha;
#pragma unroll
      for (int kt = 0; kt < 2; ++kt) {
        if (kt == 0 || act1) {
#pragma unroll
          for (int ss = 0; ss < 2; ++ss) {
            u32x4 pk = {pack2(scur[kt][8 * ss], scur[kt][8 * ss + 1]), pack2(scur[kt][8 * ss + 2], scur[kt][8 * ss + 3]),
                        pack2(scur[kt][8 * ss + 4], scur[kt][8 * ss + 5]), pack2(scur[kt][8 * ss + 6], scur[kt][8 * ss + 7])};
            const bf16x8 pf = as_frag(pk);
#pragma unroll
            for (int dt = 0; dt < 2; ++dt) {
              const bf16x8 vf = *(const bf16x8*)(vb + dt * 4096 + lofs[2 * kt + ss]);
              oacc[dt] = MFMA(vf, pf, oacc[dt]);
            }
            lacc = MFMA(onesf, pf, lacc);
          }
        }
      }
    }
    lstore(b2, kreg, vreg);
    gload((tix + 4 < ntile) ? tix + 4 : ntile - 1, kreg, vreg);
    __syncthreads();
  };
  gload(0, kregA, vregA);
  gload(1, kregB, vregB);
  lstore(0, kregA, vregA);
  gload((2 < ntile) ? 2 : ntile - 1, kregA, vregA);
  lstore(1, kregB, vregB);
  gload((3 < ntile) ? 3 : ntile - 1, kregB, vregB);
  __syncthreads();
  f32x16 sa[2], sb[2];
  sa[0] = zero16; sa[1] = zero16; sb[0] = zero16; sb[1] = zero16;
  compute_s(0, 0, sa);
  {
    int b0 = 0;
#pragma unroll 1
    for (int tix = 0; tix < ntile; tix += 2) {
      const int b1 = (b0 == 2) ? 0 : b0 + 1;
      const int b2 = (b1 == 2) ? 0 : b1 + 1;
      step(tix, b0, b1, b2, sa, sb, kregA, vregA);
      if (tix + 1 < ntile) step(tix + 1, b1, b2, b0, sb, sa, kregB, vregB);
      b0 = b2;
    }
  }
  {
    const float ltot = __shfl(lacc[0], r);
    const float inv = 1.f / ltot;
    bfu* ym = (bfu*)(p.ws + OFF_HBUF);
#pragma unroll
    for (int dt = 0; dt < 2; ++dt) {
      u32x2 ob[4], azp[4];
      load_pair16(proj + qtoken * 3072 + 1536 + h * 64 + dt * 32, hh, azp[0], azp[1]);
      load_pair16(proj + qtoken * 3072 + 1536 + h * 64 + dt * 32 + 16, hh, azp[2], azp[3]);
#pragma unroll
      for (int g4 = 0; g4 < 4; ++g4) {
        const u32x2 az = azp[g4];
        const float y0 = oacc[dt][4 * g4] * inv * bflo(az[0]);
        const float y1 = oacc[dt][4 * g4 + 1] * inv * bfhi(az[0]);
        const float y2 = oacc[dt][4 * g4 + 2] * inv * bflo(az[1]);
        const float y3 = oacc[dt][4 * g4 + 3] * inv * bfhi(az[1]);
        ob[g4][0] = pack2(y0, y1); ob[g4][1] = pack2(y2, y3);
      }
      store_pair16(ym + qtoken * 1024 + h * 64 + dt * 32, ob[0], ob[1], hh);
      store_pair16(ym + qtoken * 1024 + h * 64 + dt * 32 + 16, ob[2], ob[3], hh);
    }
  }
}

DI void mlstm_out_item(const Params& p, int it) {
  const int lane = tid_l() & 63, r = lane & 31, hh = lane >> 5;
  const int bh = it >> 7, c = (it >> 1) & 63, tt = it & 1;
  const int b = bh >> 2, h = bh & 3;
  const size_t tok0 = (size_t)b * 4096 + c * 64;
  const bfu* proj = (const bfu*)(p.ws + OFF_PROJ);
  const bfu* qm = (const bfu*)(p.ws + OFF_QM);
  const bfu* km = (const bfu*)(p.ws + OFF_KM);
  const bfu* vm = (const bfu*)(p.ws + OFF_VM);
  const bfu* xcb = (const bfu*)(p.ws + OFF_XC);
  const bfu* cst = (const bfu*)(p.ws + OFF_UST) + (size_t)(bh * 64 + c) * 129 * 128;
  const float* cumv = (const float*)(p.ws + OFF_CUM) + (size_t)bh * 4096 + c * 64;
  const float* agv = (const float*)(p.ws + OFF_AG) + (size_t)bh * 4096 + c * 64;
  bfu* ym = (bfu*)(p.ws + OFF_HBUF);
  {
    const size_t token = tok0 + 32 * tt + r;
    u32x4 qf[8];
#pragma unroll
    for (int kk = 0; kk < 8; ++kk) qf[kk] = *(const u32x4*)(qm + token * 512 + h * 128 + 16 * kk + 8 * hh);
    const float cum_t = cumv[32 * tt + r];
    const float e_t = __expf(cum_t);
    float dn;
    {
      f32x16 an;
#pragma unroll
      for (int i = 0; i < 16; ++i) an[i] = 0.f;
#pragma unroll
      for (int kk = 0; kk < 8; ++kk) {
        u32x4 cv = {0u, 0u, 0u, 0u};
        if (r == 0) cv = *(const u32x4*)(cst + (size_t)128 * 128 + 16 * kk + 8 * hh);
        an = MFMA(as_frag(cv), as_frag(qf[kk]), an);
      }
      dn = __shfl(an[0], r);
    }
    f32x16 ai[4];
#pragma unroll
    for (int vt = 0; vt < 4; ++vt) {
#pragma unroll
      for (int i = 0; i < 16; ++i) ai[vt][i] = 0.f;
#pragma unroll
      for (int kk = 0; kk < 8; ++kk) {
        const u32x4 cv = *(const u32x4*)(cst + (size_t)(vt * 32 + r) * 128 + 16 * kk + 8 * hh);
        ai[vt] = MFMA(as_frag(cv), as_frag(qf[kk]), ai[vt]);
      }
#pragma unroll
      for (int i = 0; i < 16; ++i) ai[vt][i] *= e_t;
    }
    float den_i = 0.f;
#pragma unroll 1
    for (int st = 0; st <= tt; ++st) {
      f32x16 sacc;
#pragma unroll
      for (int i = 0; i < 16; ++i) sacc[i] = 0.f;
#pragma unroll
      for (int kk = 0; kk < 8; ++kk) {
        const bf16x8 kf = as_frag(*(const u32x4*)(km + (tok0 + 32 * st + r) * 512 + h * 128 + 16 * kk + 8 * hh));
        sacc = MFMA(kf, as_frag(qf[kk]), sacc);
      }
      const int tl = 32 * tt + r;
#pragma unroll
      for (int g4 = 0; g4 < 4; ++g4) {
        const float4 av = *(const float4*)(agv + 32 * st + 8 * g4 + 4 * hh);
        const float aa[4] = {av.x, av.y, av.z, av.w};
#pragma unroll
        for (int q = 0; q < 4; ++q) {
          const int s = 32 * st + 8 * g4 + 4 * hh + q;
          const float wgt = (s <= tl) ? sacc[4 * g4 + q] * __expf(cum_t + aa[q]) : 0.f;
          sacc[4 * g4 + q] = wgt;
          den_i += wgt;
        }
      }
#pragma unroll
      for (int ss = 0; ss < 2; ++ss) {
        u32x4 pk = {pack2(sacc[8 * ss], sacc[8 * ss + 1]), pack2(sacc[8 * ss + 2], sacc[8 * ss + 3]),
                    pack2(sacc[8 * ss + 4], sacc[8 * ss + 5]), pack2(sacc[8 * ss + 6], sacc[8 * ss + 7])};
        const bf16x8 pf = as_frag(pk);
#pragma unroll
        for (int vt = 0; vt < 4; ++vt) {
          const bfu* vp = vm + ((size_t)(bh * 64 + c) * 128 + vt * 32 + r) * 64 + 32 * st + 16 * ss + 4 * hh;
          const u32x2 lo = *(const u32x2*)vp;
          const u32x2 hi = *(const u32x2*)(vp + 8);
          u32x4 vv = {lo[0], lo[1], hi[0], hi[1]};
          ai[vt] = MFMA(as_frag(vv), pf, ai[vt]);
        }
      }
    }
    den_i += __shfl_xor(den_i, 32);
    const float den = den_i + e_t * dn;
    const float inv = 1.f / fmaxf(fabsf(den), 1.f);
    float s1 = 0.f;
#pragma unroll
    for (int vt = 0; vt < 4; ++vt)
#pragma unroll
      for (int i = 0; i < 16; ++i) {
        const float hv = ai[vt][i] * inv;
        ai[vt][i] = hv;
        s1 += hv;
      }
    s1 += __shfl_xor(s1, 32);
    const float mean = s1 * (1.f / 128.f);
    float s2 = 0.f;
#pragma unroll
    for (int vt = 0; vt < 4; ++vt)
#pragma unroll
      for (int i = 0; i < 16; ++i) { const float d = ai[vt][i] - mean; s2 += d * d; }
    s2 += __shfl_xor(s2, 32);
    const float rstd = rsqrtf(s2 * (1.f / 128.f) + 1e-5f);
#pragma unroll
    for (int vt = 0; vt < 4; ++vt) {
      u32x2 ob[4], xvp[4], zvp[4];
#pragma unroll
      for (int gp = 0; gp < 2; ++gp) {
        load_pair16(xcb + token * 512 + h * 128 + 32 * vt + 16 * gp, hh, xvp[2 * gp], xvp[2 * gp + 1]);
        load_pair16(proj + token * 3072 + 2560 + h * 128 + 32 * vt + 16 * gp, hh, zvp[2 * gp], zvp[2 * gp + 1]);
      }
#pragma unroll
      for (int g4 = 0; g4 < 4; ++g4) {
        const int v = 32 * vt + 8 * g4 + 4 * hh;
        const float4 og = *(const float4*)(p.out_g + h * 128 + v);
        const float4 sk = *(const float4*)(p.skip + h * 128 + v);
        const u32x2 xv = xvp[g4];
        const u32x2 zv = zvp[g4];
        const float y0 = ((ai[vt][4 * g4] - mean) * rstd * og.x + sk.x * bflo(xv[0])) * bflo(zv[0]);
        const float y1 = ((ai[vt][4 * g4 + 1] - mean) * rstd * og.y + sk.y * bfhi(xv[0])) * bfhi(zv[0]);
        const float y2 = ((ai[vt][4 * g4 + 2] - mean) * rstd * og.z + sk.z * bflo(xv[1])) * bflo(zv[1]);
        const float y3 = ((ai[vt][4 * g4 + 3] - mean) * rstd * og.w + sk.w * bfhi(xv[1])) * bfhi(zv[1]);
        ob[g4][0] = pack2(y0, y1); ob[g4][1] = pack2(y2, y3);
      }
      store_pair16(ym + token * 1024 + 512 + h * 128 + 32 * vt, ob[0], ob[1], hh);
      store_pair16(ym + token * 1024 + 512 + h * 128 + 32 * vt + 16, ob[2], ob[3], hh);
    }
  }
}

DI void sgu_item(const Params& p, int it, char* smem) {
  const int tid = tid_l(), lane = tid & 63, w = tid >> 6, r = lane & 31, hh = lane >> 5;
  const int g = it & 7, n = (it >> 3) & 31, b = it >> 8;
  const size_t tok0 = (size_t)b * 4096 + n * 128;
  float* sMu = (float*)smem;
  float* sRs = sMu + 128;
  if (tid < 128) {
    const float* st = (const float*)(p.ws + OFF_STATS) + (tok0 + tid) * 32;
    float s1 = 0.f, s2 = 0.f;
#pragma unroll
    for (int q = 0; q < 16; ++q) { s1 += st[2 * q]; s2 += st[2 * q + 1]; }
    const float mean = s1 * (1.f / 1024.f);
    const float var = fmaxf(s2 * (1.f / 1024.f) - mean * mean, 0.f);
    sMu[tid] = mean;
    sRs[tid] = rsqrtf(var + 1e-5f);
  }
  __syncthreads();
  const int cch = g * 128 + w * 32 + r;
  const float lng = p.c_ln_g[cch], lnb = p.c_ln_b[cch];
  const bfu* gvt = (const bfu*)(p.ws + OFF_GVT) + ((size_t)b * 1024 + cch) * 4096 + n * 128;
  const bfu* wsb = (const bfu*)(p.ws + OFF_WSB) + (size_t)g * 128 * 128;
  const bfu* proj = (const bfu*)(p.ws + OFF_PROJ);
  f32x16 acc[4];
#pragma unroll
  for (int tt = 0; tt < 4; ++tt)
#pragma unroll
    for (int i = 0; i < 16; ++i) acc[tt][i] = 0.f;
#pragma unroll
  for (int ks = 0; ks < 8; ++ks) {
    const u32x4 raw = *(const u32x4*)(gvt + 16 * ks + 8 * hh);
    float f[8];
#pragma unroll
    for (int q = 0; q < 4; ++q) { f[2 * q] = bflo(raw[q]); f[2 * q + 1] = bfhi(raw[q]); }
#pragma unroll
    for (int j = 0; j < 8; ++j) {
      const int s = 16 * ks + 8 * hh + j;
      f[j] = (f[j] - sMu[s]) * sRs[s] * lng + lnb;
    }
    u32x4 pk = {pack2(f[0], f[1]), pack2(f[2], f[3]), pack2(f[4], f[5]), pack2(f[6], f[7])};
    const bf16x8 af = as_frag(pk);
#pragma unroll
    for (int tt = 0; tt < 4; ++tt) {
      if (32 * tt + 31 >= 16 * ks) {
        const bf16x8 bfr = as_frag(*(const u32x4*)(wsb + (size_t)(32 * tt + r) * 128 + 16 * ks + 8 * hh));
        acc[tt] = MFMA(af, bfr, acc[tt]);
      }
    }
  }
  bfu* ym = (bfu*)(p.ws + OFF_HBUF);
#pragma unroll
  for (int tt = 0; tt < 4; ++tt) {
    const int t = 32 * tt + r;
    const size_t token = tok0 + t;
    const float bsv = p.c_bs[g * 128 + t];
    u32x2 ob[4], uvp[4], zvp[4];
#pragma unroll
    for (int gp = 0; gp < 2; ++gp) {
      load_pair16(proj + token * 3072 + g * 128 + w * 32 + 16 * gp, hh, uvp[2 * gp], uvp[2 * gp + 1]);
      load_pair16(proj + token * 3072 + 2048 + g * 128 + w * 32 + 16 * gp, hh, zvp[2 * gp], zvp[2 * gp + 1]);
    }
#pragma unroll
    for (int g4 = 0; g4 < 4; ++g4) {
      const u32x2 uv = uvp[g4];
      const u32x2 zv = zvp[g4];
      const float y0 = bflo(uv[0]) * (acc[tt][4 * g4] + bsv) * bflo(zv[0]);
      const float y1 = bfhi(uv[0]) * (acc[tt][4 * g4 + 1] + bsv) * bfhi(zv[0]);
      const float y2 = bflo(uv[1]) * (acc[tt][4 * g4 + 2] + bsv) * bflo(zv[1]);
      const float y3 = bfhi(uv[1]) * (acc[tt][4 * g4 + 3] + bsv) * bfhi(zv[1]);
      ob[g4][0] = pack2(y0, y1); ob[g4][1] = pack2(y2, y3);
    }
    store_pair16(ym + token * 1024 + g * 128 + w * 32, ob[0], ob[1], hh);
    store_pair16(ym + token * 1024 + g * 128 + w * 32 + 16, ob[2], ob[3], hh);
  }
  __syncthreads();
}

#ifndef ONLY_PH
#define ONLY_PH -1
#endif
#define PH_ON(x) (ONLY_PH < 0 || ONLY_PH == (x))
template <int ph>
DI void run_phase(const Params& pin, char* smem, bool rep) {
  const int G = gridDim.x, bid = blockIdx.x;
  if (!PH_ON(ph)) return;
  const Params& p = pin;
  switch (ph) {
    case 0: if (PH_ON(0)) {
      for (int it = bid; it < 1156; it += G) {
        if (it < 384) mod_item(p, it, (float*)smem);
        else if (it < 1152) { const int t = it - 384; transpose_tile(p.w_in, (bfu*)(p.ws + OFF_WTIN), 1024, 3072, (t & 15) * 64, (t >> 4) * 64, (float*)smem); }
        else gt_item(p, it - 1152);
      }
    } break;
    case 1: if (PH_ON(1))
      for (int it = bid; it < 512 + 96; it += G) { if (it < 512) norm_item(p, p.x, 0, it, (float*)smem); else modfin_item(p, it - 512); }
      break;
    case 2: if (PH_ON(2))
      if ((G & 7) == 0) {
        const int x = bid & 7;
        for (int lt = bid >> 3; lt < 192; lt += G >> 3)
          gemm_tile<0>(p, (const bfu*)(p.ws + OFF_HBUF), (const bfu*)(p.ws + OFF_WTIN), (x * 8 + lt / 24) * 256, (lt % 24) * 128, smem, 0, nullptr);
      } else {
        for (int t = bid; t < 64 * 24; t += G)
          gemm_tile<0>(p, (const bfu*)(p.ws + OFF_HBUF), (const bfu*)(p.ws + OFF_WTIN), (t / 24) * 256, (t % 24) * 128, smem, 0, nullptr);
      }
      break;
    case 3: if (PH_ON(3)) {
      const bool split = (G >= 512);
      for (int it = bid; it < 1600; it += (split ? (bid < 256 ? 1600 : G - 256) : G)) {
        if (it < 256) mlstm_prep_item(p, it, smem);
        else if (it < 1024) { const int t = it - 256; transpose_tile(p.w_in + (size_t)1024 * 3072, (bfu*)(p.ws + OFF_WTIN), 1024, 3072, (t & 15) * 64, (t >> 4) * 64, (float*)smem); }
        else if (it < 1280) { const int t = it - 1024; transpose_tile(p.w_out, (bfu*)(p.ws + OFF_WTOUT0), 1024, 1024, (t & 15) * 64, (t >> 4) * 64, (float*)smem); }
        else if (it < 1536) { const int t = it - 1280; transpose_tile(p.w_out + 1024 * 1024, (bfu*)(p.ws + OFF_WTOUT1), 1024, 1024, (t & 15) * 64, (t >> 4) * 64, (float*)smem); }
        else wsb_item(p, it - 1536);
      }
    } break;
    case 4: if (PH_ON(4)) {
      for (int it = bid; it < 129; it += G) { if (!rep) scan_item(p, it); }
      if ((G & 7) == 0) {
        const int x = bid & 7, nl = G >> 3, local = bid >> 3;
        for (int rd = 0; rd * nl < 128; ++rd) {
          const int li = (rd & 1) ? (rd + 1) * nl - 1 - local : rd * nl + local;
          if (li >= 128 || li < 0) continue;
          const int jj = li >> 3, rem = li & 7;
          moba_item(p, (jj << 6) | ((rem >> 2) << 5) | (x * 4 + (rem & 3)), smem);
        }
      } else {
        for (int rd = 0; rd * G < 1024; ++rd) {
          const int pos = (rd & 1) ? (rd + 1) * G - 1 - bid : rd * G + bid;
          if (pos >= 1024) continue;
          moba_item(p, pos, smem);
        }
      }
    } break;
    case 5: if (PH_ON(5)) {
      const int gw = __builtin_amdgcn_readfirstlane(bid * 4 + (tid_l() >> 6));
      for (int it = gw; it < 2048; it += G * 4) mlstm_out_item(p, it);
    } break;
    case 6: if (PH_ON(6))
      if ((G & 7) == 0) {
        const int x = bid & 7;
        for (int lt = bid >> 3; lt < 64; lt += G >> 3)
          gemm_tile<1>(p, (const bfu*)(p.ws + OFF_HBUF), (const bfu*)(p.ws + OFF_WTOUT0), (x * 8 + lt / 8) * 256, (lt % 8) * 128, smem, 0, p.x);
      } else {
        for (int t = bid; t < 64 * 8; t += G)
          gemm_tile<1>(p, (const bfu*)(p.ws + OFF_HBUF), (const bfu*)(p.ws + OFF_WTOUT0), (t / 8) * 256, (t % 8) * 128, smem, 0, p.x);
      }
      break;
    case 7: if (PH_ON(7))
      for (int it = bid; it < 512; it += G) norm_item(p, p.out, 1, it, (float*)smem);
      break;
    case 8: if (PH_ON(8))
      if ((G & 7) == 0) {
        const int x = bid & 7;
        for (int lt = bid >> 3; lt < 192; lt += G >> 3)
          gemm_tile<2>(p, (const bfu*)(p.ws + OFF_HBUF), (const bfu*)(p.ws + OFF_WTIN), (x * 8 + lt / 24) * 256, (lt % 24) * 128, smem, 1, nullptr);
      } else {
        for (int t = bid; t < 64 * 24; t += G)
          gemm_tile<2>(p, (const bfu*)(p.ws + OFF_HBUF), (const bfu*)(p.ws + OFF_WTIN), (t / 24) * 256, (t % 24) * 128, smem, 1, nullptr);
      }
      break;
    case 9: if (PH_ON(9))
      for (int it = bid; it < 1024; it += G) sgu_item(p, it, smem);
      break;
    case 10: if (PH_ON(10))
      if ((G & 7) == 0) {
        const int x = bid & 7;
        for (int lt = bid >> 3; lt < 64; lt += G >> 3)
          gemm_tile<1>(p, (const bfu*)(p.ws + OFF_HBUF), (const bfu*)(p.ws + OFF_WTOUT1), (x * 8 + lt / 8) * 256, (lt % 8) * 128, smem, 1, p.out);
      } else {
        for (int t = bid; t < 64 * 8; t += G)
          gemm_tile<1>(p, (const bfu*)(p.ws + OFF_HBUF), (const bfu*)(p.ws + OFF_WTOUT1), (t / 8) * 256, (t % 8) * 128, smem, 1, p.out);
      }
      break;
    default: break;
  }
}


#define XB_TMO      128
#define XB_XCNT(j)  (256  + 64 * (j))
#define XB_XSUB(j)  (1280 + 64 * (j))
#define XB_XGEN(j)  (2304 + 64 * (j))
#define XB_TOP      3328
#define XB_TOPGEN   3392
#define XCD_BAR_WORDS 3456
#define XB_SPIN_CAP (1u << 18)
#define LAS __attribute__((address_space(3)))

__device__ __forceinline__ unsigned xb_ld(unsigned* p)              { return __hip_atomic_load(p, __ATOMIC_RELAXED, __HIP_MEMORY_SCOPE_AGENT); }
__device__ __forceinline__ unsigned xb_add(unsigned* p, unsigned v) { return __hip_atomic_fetch_add(p, v, __ATOMIC_RELAXED, __HIP_MEMORY_SCOPE_AGENT); }
__device__ __forceinline__ unsigned xb_xcc_id() { return (unsigned)__builtin_amdgcn_s_getreg((3 << 11) | 20) & 0xFu; }
#define XB_SPIN(cond, bar) do { unsigned _sp = 0; while (cond) { __builtin_amdgcn_s_sleep(1); \
    if ((++_sp & 255u) == 0u) { if (xb_ld(&(bar)[XB_TMO])) break; if (_sp > XB_SPIN_CAP) { atomicAdd(&(bar)[XB_TMO], 1u); break; } } } } while (0)

struct XcdBarrier {
    unsigned* bar; unsigned x;
    volatile LAS unsigned* st;
};

__device__ __forceinline__ XcdBarrier xcd_barrier_post(unsigned* bar, volatile LAS unsigned* st) {
    XcdBarrier b; b.bar = bar; b.x = xb_xcc_id(); b.st = st;
    if (threadIdx.x == 0) (void)xb_add(&bar[XB_XCNT(b.x)], 1u);
    return b;
}
__device__ __forceinline__ void xcd_barrier_complete(unsigned* bar, unsigned x, unsigned& nloc, unsigned& nx) {
    const unsigned G = gridDim.x * gridDim.y * gridDim.z;
    unsigned sum, cnt, mine, sp = 0u;
    for (;;) {
        sum = 0u; cnt = 0u; mine = 0u;
#pragma unroll
        for (unsigned j = 0; j < 16; ++j) { const unsigned c = xb_ld(&bar[XB_XCNT(j)]); sum += c; cnt += (c > 0u) ? 1u : 0u; mine = (j == x) ? c : mine; }
        if (sum == G) break;
        __builtin_amdgcn_s_sleep(1);
        if ((++sp & 255u) == 0u) { if (xb_ld(&bar[XB_TMO])) break; if (sp > XB_SPIN_CAP) { atomicAdd(&bar[XB_TMO], 1u); break; } }
    }
    nloc = mine > 0u ? mine : 1u; nx = cnt > 0u ? cnt : 1u;
}

__device__ __forceinline__ void xcd_barrier(const XcdBarrier& b) {
    asm volatile("s_waitcnt vmcnt(0)" ::: "memory");
    __syncthreads();
    if (threadIdx.x == 0) {
        unsigned* bar = b.bar;
        __builtin_amdgcn_s_waitcnt(0);
        unsigned nloc = b.st[0], nx = b.st[1];
        if (nloc == 0u) { xcd_barrier_complete(bar, b.x, nloc, nx); b.st[0] = nloc; b.st[1] = nx; }
        const unsigned old = xb_add(&bar[XB_XSUB(b.x)], 1u);
        const unsigned gen = old / nloc;
        if (old + 1u == (gen + 1u) * nloc) {
            __builtin_amdgcn_fence(__ATOMIC_RELEASE, "agent");
            asm volatile("s_waitcnt vmcnt(0)" ::: "memory");
            const unsigned og = xb_add(&bar[XB_TOP], 1u);
            const unsigned tg = og / nx;
            if (og + 1u == (tg + 1u) * nx) xb_add(&bar[XB_TOPGEN], 1u);
            else XB_SPIN(xb_ld(&bar[XB_TOPGEN]) == tg, bar);
            __builtin_amdgcn_fence(__ATOMIC_ACQUIRE, "agent");
            xb_add(&bar[XB_XGEN(b.x)], 1u);
            asm volatile("s_waitcnt vmcnt(0)" ::: "memory");
        } else {
            XB_SPIN(xb_ld(&bar[XB_XGEN(b.x)]) == gen, bar);
            __builtin_amdgcn_fence(__ATOMIC_ACQUIRE, "agent");
            asm volatile("s_waitcnt vmcnt(0)" ::: "memory");
        }
    }
    __syncthreads();
}


constexpr int NPHASE = 11;

__global__ void __launch_bounds__(256, 2) fwd_mega(Params p, int never) {
  __shared__ __attribute__((aligned(16))) char smem[65536];
  cg::grid_group grid = cg::this_grid();
  if (never < 0) grid.sync();
  __shared__ uint4 xb_words;
  if (threadIdx.x == 0) xb_words = make_uint4(0u, 0u, 0u, 0u);
  __syncthreads();
  XcdBarrier xb = xcd_barrier_post((unsigned*)(p.ws + OFF_BAR), (volatile LAS unsigned*)&xb_words);
#ifndef REP_PH
#define REP_PH -1
#endif
#define PHASE(n)                                                      \
  run_phase<n>(p, smem, false);                                       \
  if (REP_PH == n) { xcd_barrier(xb); run_phase<n>(p, smem, true); }  \
  if (n + 1 < NPHASE) xcd_barrier(xb);
  PHASE(0) PHASE(1) PHASE(2) PHASE(3) PHASE(4) PHASE(5) PHASE(6) PHASE(7) PHASE(8) PHASE(9) PHASE(10)
}

extern "C" void kernel_launch(void* const* d_in, const int* in_sizes, int n_in, void* d_out, int out_size, void* d_ws,
                              size_t ws_size, hipStream_t stream) {
  Params p{};
  p.x = (const float*)d_in[0]; p.c = (const float*)d_in[1]; p.ln_g = (const float*)d_in[2];
  p.ada_w = (const float*)d_in[3]; p.ada_b = (const float*)d_in[4]; p.w_in = (const float*)d_in[5];
  p.w_out = (const float*)d_in[6]; p.a_q_g = (const float*)d_in[7]; p.a_k_g = (const float*)d_in[8];
  p.conv_w = (const float*)d_in[9]; p.conv_b = (const float*)d_in[10]; p.wq = (const float*)d_in[11];
  p.wk = (const float*)d_in[12]; p.wv = (const float*)d_in[13]; p.w_gates = (const float*)d_in[14];
  p.b_gates = (const float*)d_in[15]; p.out_g = (const float*)d_in[16]; p.skip = (const float*)d_in[17];
  p.c_ln_g = (const float*)d_in[18]; p.c_ln_b = (const float*)d_in[19]; p.c_ws = (const float*)d_in[20];
  p.c_bs = (const float*)d_in[21];
  p.out = (float*)d_out;
  p.ws = (char*)d_ws;
  static int grid_blocks = 0;
  if (!grid_blocks) {
    int dev = 0, cus = 0, per_cu = 0;
    hipGetDevice(&dev);
    hipDeviceGetAttribute(&cus, hipDeviceAttributeMultiprocessorCount, dev);
    hipOccupancyMaxActiveBlocksPerMultiprocessor(&per_cu, fwd_mega, 256, 0);
    if (per_cu > 2) per_cu = 2;
    if (per_cu < 1) per_cu = 1;
    grid_blocks = cus * per_cu;
  }
  hipMemsetAsync((char*)d_ws + OFF_BAR, 0, XCD_BAR_WORDS * 4, stream);
  int never = 0;
  void* args[] = {&p, &never};
  hipError_t e = hipLaunchCooperativeKernel((void*)fwd_mega, dim3(grid_blocks), dim3(256), args, 0, stream);
  if (e != hipSuccess) fprintf(stderr, "cooperative launch failed: %s (grid %d)\n", hipGetErrorString(e), grid_blocks);
}
```

```cpp
#include <hip/hip_runtime.h>
#include <hip/hip_cooperative_groups.h>
#include <stdint.h>
#include <cstdio>
#include <type_traits>
namespace cg = cooperative_groups;
#define DI __device__ __forceinline__

#ifndef MK_FUSED
#define MK_FUSED 1
#endif

typedef unsigned short bfu;
typedef short bf16x8 __attribute__((ext_vector_type(8)));
typedef float f32x16 __attribute__((ext_vector_type(16)));
typedef float f32x2 __attribute__((ext_vector_type(2)));
typedef __bf16 bf16x2v __attribute__((ext_vector_type(2)));
typedef unsigned u32x4 __attribute__((ext_vector_type(4)));
typedef unsigned u32x2 __attribute__((ext_vector_type(2)));

#define MFMA(a, b, c) __builtin_amdgcn_mfma_f32_32x32x16_bf16((a), (b), (c), 0, 0, 0)

DI unsigned pack2(float a, float b) { f32x2 v = {a, b}; bf16x2v r = __builtin_convertvector(v, bf16x2v); return __builtin_bit_cast(unsigned, r); }
DI float bflo(unsigned u) { return __uint_as_float(u << 16); }
DI float bfhi(unsigned u) { return __uint_as_float(u & 0xffff0000u); }
DI bfu f2bf(float a) { return (bfu)(pack2(a, 0.f) & 0xffffu); }
DI float bf2f(bfu h) { return __uint_as_float(((unsigned)h) << 16); }
DI int tid_l() { int t = threadIdx.x; asm volatile("" : "+v"(t)); return t; }
DI int crow(int i, int hh) { return (i & 3) + 8 * (i >> 2) + 4 * hh; }
DI float silu_f(float x) { return x * __builtin_amdgcn_rcpf(1.f + __builtin_amdgcn_exp2f(-1.4426950408889634f * x)); }
DI float gelu_f(float x) {
  const float u2 = 2.3022081981443144f * (x + 0.044715f * x * x * x);
  return x * __builtin_amdgcn_rcpf(1.f + __builtin_amdgcn_exp2f(-u2));
}
DI bf16x8 as_frag(u32x4 v) { return __builtin_bit_cast(bf16x8, v); }
DI void load_pair16(const bfu* p0, int hh, u32x2& a, u32x2& b) {
  const u32x4 l = *(const u32x4*)(p0 + 8 * hh);
  const auto s0 = __builtin_amdgcn_permlane32_swap(l[0], l[2], false, false);
  const auto s1 = __builtin_amdgcn_permlane32_swap(l[1], l[3], false, false);
  a[0] = s0[0]; a[1] = s1[0]; b[0] = s0[1]; b[1] = s1[1];
}
DI void store_pair16(bfu* p0, u32x2 a, u32x2 b, int hh) {
  const auto s0 = __builtin_amdgcn_permlane32_swap(a[0], b[0], false, false);
  const auto s1 = __builtin_amdgcn_permlane32_swap(a[1], b[1], false, false);
  u32x4 o = {s0[0], s1[0], s0[1], s1[1]};
  *(u32x4*)(p0 + 8 * hh) = o;
}

constexpr int NB = 4, SEQ = 4096, DM = 1024, NTOK = NB * SEQ;

constexpr size_t OFF_WTIN   = 0;
constexpr size_t OFF_WTOUT0 = OFF_WTIN + 6291456;
constexpr size_t OFF_WTOUT1 = OFF_WTOUT0 + 2097152;
constexpr size_t OFF_WSB    = OFF_WTOUT1 + 2097152;
constexpr size_t OFF_GT     = OFF_WSB + 262144;
constexpr size_t OFF_MODP   = OFF_GT + 65536;
constexpr size_t OFF_KSUM   = OFF_MODP + 1572864;
constexpr size_t OFF_CUM    = OFF_KSUM + 524288;
constexpr size_t OFF_AG     = OFF_CUM + 262144;
constexpr size_t OFF_TOT    = OFF_AG + 262144;
constexpr size_t OFF_HBUF   = OFF_TOT + 4096;
constexpr size_t OFF_PROJ   = OFF_HBUF + 33554432;
constexpr size_t OFF_MIX    = OFF_PROJ + 100663296;
constexpr size_t OFF_VT     = OFF_MIX;
constexpr size_t OFF_QM     = OFF_MIX + 16777216;
constexpr size_t OFF_KM     = OFF_QM + 16777216;
constexpr size_t OFF_VM     = OFF_KM + 16777216;
constexpr size_t OFF_XC     = OFF_VM + 16777216;
constexpr size_t OFF_UST    = OFF_XC + 16777216;
constexpr size_t OFF_END    = OFF_UST + 33816576;
constexpr size_t OFF_KT     = OFF_HBUF;
constexpr size_t OFF_GVT    = OFF_MIX;
constexpr size_t OFF_STATS  = OFF_MIX + 33554432;
constexpr size_t OFF_X1B    = OFF_MIX + 37748736;
constexpr size_t OFF_MODF   = OFF_END;
constexpr size_t OFF_BAR    = OFF_MODF + 98304;
static_assert(OFF_BAR + 16384 <= 268435456ull, "workspace overflow");

struct Params {
  const float *x, *c, *ln_g, *ada_w, *ada_b, *w_in, *w_out, *a_q_g, *a_k_g, *conv_w, *conv_b, *wq, *wk, *wv,
      *w_gates, *b_gates, *out_g, *skip, *c_ln_g, *c_ln_b, *c_ws, *c_bs;
  float* out;
  char* ws;
};

DI void transpose_tile(const float* __restrict__ src, bfu* __restrict__ dst, int K, int N, int k0, int n0, float* st) {
  const int tid = tid_l();
#pragma unroll
  for (int i = 0; i < 4; ++i) {
    const int r = (tid >> 4) + 16 * i, c4 = tid & 15;
    typedef float f32x4n __attribute__((ext_vector_type(4)));
    const f32x4n v = __builtin_nontemporal_load((const f32x4n*)(src + (size_t)(k0 + r) * N + n0 + 4 * c4));
    float* d = st + r * 65 + 4 * c4;
    d[0] = v.x; d[1] = v.y; d[2] = v.z; d[3] = v.w;
  }
  __syncthreads();
#pragma unroll
  for (int i = 0; i < 2; ++i) {
    const int n = (tid >> 3) + 32 * i, kc = tid & 7;
    float f[8];
#pragma unroll
    for (int j = 0; j < 8; ++j) f[j] = st[(8 * kc + j) * 65 + n];
    u32x4 o = {pack2(f[0], f[1]), pack2(f[2], f[3]), pack2(f[4], f[5]), pack2(f[6], f[7])};
    *(u32x4*)(dst + (size_t)(n0 + n) * K + k0 + 8 * kc) = o;
  }
  __syncthreads();
}

DI void mod_item(const Params& p, int it, float* sm) {
  const int layer = it / 192, rem = it % 192, cgp = rem >> 4, ks = rem & 15;
  const int tid = tid_l();
  {
    const int b = tid >> 6, kk = tid & 63;
    const float cv = p.c[b * 1024 + ks * 64 + kk];
    sm[tid] = silu_f(cv);
  }
  __syncthreads();
  const int col = cgp * 256 + tid;
  const float* w = p.ada_w + (size_t)layer * 1024 * 3072 + (size_t)(ks * 64) * 3072 + col;
  float a0 = 0.f, a1 = 0.f, a2 = 0.f, a3 = 0.f;
#pragma unroll 16
  for (int kk = 0; kk < 64; ++kk) {
    const float wv = __builtin_nontemporal_load(w + (size_t)kk * 3072);
    a0 += sm[kk] * wv; a1 += sm[64 + kk] * wv; a2 += sm[128 + kk] * wv; a3 += sm[192 + kk] * wv;
  }
  float* o = (float*)(p.ws + OFF_MODP) + (size_t)((layer * 16 + ks) * 4) * 3072 + col;
  o[0] = a0; o[3072] = a1; o[2 * 3072] = a2; o[3 * 3072] = a3;
  __syncthreads();
}

DI void gt_item(const Params& p, int it) {
  const int ch = it * 256 + tid_l();
  bfu* gt = (bfu*)(p.ws + OFF_GT);
  for (int n = 0; n < 8; ++n) {
    float val = 0.f;
    if (ch < 512) {
      const int g = ch >> 2, ii = ch & 3;
      for (int o = 0; o < 4; ++o) {
        val += p.wq[g * 16 + ii * 4 + o] * p.w_gates[(4 * g + o) * 8 + n];
        val += p.wk[g * 16 + ii * 4 + o] * p.w_gates[(512 + 4 * g + o) * 8 + n];
      }
    } else {
      const int c2 = ch - 512, g = c2 >> 2, ii = c2 & 3;
      for (int o = 0; o < 4; ++o) val += p.wv[g * 16 + ii * 4 + o] * p.w_gates[(1024 + 4 * g + o) * 8 + n];
    }
    gt[n * 1024 + ch] = f2bf(val);
  }
  for (int n = 8; n < 32; ++n) gt[n * 1024 + ch] = 0;
}

DI void wsb_item(const Params& p, int it) {
  const int e = (it * 256 + tid_l()) * 8;
  const int t = (e >> 7) & 127, s0 = e & 127;
  float f[8];
#pragma unroll
  for (int j = 0; j < 8; ++j) f[j] = (s0 + j <= t) ? p.c_ws[e + j] : 0.f;
  u32x4 o = {pack2(f[0], f[1]), pack2(f[2], f[3]), pack2(f[4], f[5]), pack2(f[6], f[7])};
  *(u32x4*)((bfu*)(p.ws + OFF_WSB) + e) = o;
}

DI void norm_item(const Params& p, const float* __restrict__ xin, int layer, int it, float* sm) {
  float* sSc = sm;
  float* sSh = sm + 1024;
  const int tid = tid_l();
  const int row0 = it * 32;
  const int b = row0 >> 12;
  if (layer == 0) {
    const float* modp = (const float*)(p.ws + OFF_MODP);
#pragma unroll
    for (int cc = 0; cc < 4; ++cc) {
      const int col = tid + 256 * cc;
      float sc = p.ada_b[1024 + col], sh = p.ada_b[col];
#pragma unroll
      for (int ks = 0; ks < 16; ++ks) {
        const float* mp = modp + (size_t)(ks * 4 + b) * 3072;
        sc += mp[1024 + col];
        sh += mp[col];
      }
      sSc[col] = p.ln_g[col] * (1.f + sc);
      sSh[col] = sh;
    }
  } else {
    const float* mf = (const float*)(p.ws + OFF_MODF) + (size_t)(4 + b) * 3072;
#pragma unroll
    for (int cc = 0; cc < 4; ++cc) {
      const int col = tid + 256 * cc;
      sSc[col] = p.ln_g[1024 + col] * (1.f + mf[1024 + col]);
      sSh[col] = mf[col];
    }
  }
  __syncthreads();
  const int w = tid >> 6, lane = tid & 63;
  bfu* hb = (bfu*)(p.ws + OFF_HBUF);
#pragma unroll 1
  for (int rb = 0; rb < 2; ++rb) {
    const int rowb = row0 + w * 8 + rb * 4;
    float4 v[4][4];
    if (layer == 0) {
#pragma unroll
      for (int q = 0; q < 4; ++q)
#pragma unroll
        for (int j = 0; j < 4; ++j) v[q][j] = *(const float4*)(xin + (size_t)(rowb + q) * 1024 + lane * 4 + 256 * j);
    } else {
      const bfu* x1b = (const bfu*)(p.ws + OFF_X1B);
#pragma unroll
      for (int q = 0; q < 4; ++q)
#pragma unroll
        for (int j = 0; j < 4; ++j) {
          const u32x2 u = *(const u32x2*)(x1b + (size_t)(rowb + q) * 1024 + lane * 4 + 256 * j);
          v[q][j].x = bflo(u[0]); v[q][j].y = bfhi(u[0]); v[q][j].z = bflo(u[1]); v[q][j].w = bfhi(u[1]);
        }
    }
    float ss[4];
#pragma unroll
    for (int q = 0; q < 4; ++q) {
      float a = 0.f;
#pragma unroll
      for (int j = 0; j < 4; ++j) a += v[q][j].x * v[q][j].x + v[q][j].y * v[q][j].y + v[q][j].z * v[q][j].z + v[q][j].w * v[q][j].w;
      ss[q] = a;
    }
#pragma unroll
    for (int off = 32; off >= 1; off >>= 1)
#pragma unroll
      for (int q = 0; q < 4; ++q) ss[q] += __shfl_xor(ss[q], off);
#pragma unroll
    for (int q = 0; q < 4; ++q) {
      const float rstd = rsqrtf(ss[q] * (1.f / 1024.f) + 1e-6f);
#pragma unroll
      for (int j = 0; j < 4; ++j) {
        const int col = lane * 4 + 256 * j;
        const float4 sc4 = *(const float4*)(sSc + col);
        const float4 sh4 = *(const float4*)(sSh + col);
        const float y0 = v[q][j].x * rstd * sc4.x + sh4.x;
        const float y1 = v[q][j].y * rstd * sc4.y + sh4.y;
        const float y2 = v[q][j].z * rstd * sc4.z + sh4.z;
        const float y3 = v[q][j].w * rstd * sc4.w + sh4.w;
        u32x2 o = {pack2(y0, y1), pack2(y2, y3)};
        *(u32x2*)(hb + (size_t)(rowb + q) * 1024 + col) = o;
      }
    }
  }
  __syncthreads();
}

DI void modfin_item(const Params& p, int it) {
  const int idx = it * 256 + tid_l();
  const int layer = idx / 12288, rem = idx % 12288, b = rem / 3072, col = rem % 3072;
  const float* modp = (const float*)(p.ws + OFF_MODP);
  float a = p.ada_b[layer * 3072 + col];
#pragma unroll
  for (int ks = 0; ks < 16; ++ks) a += modp[(size_t)((layer * 16 + ks) * 4 + b) * 3072 + col];
  ((float*)(p.ws + OFF_MODF))[idx] = a;
}

#define GEMM_GL(KT)                                                                        \
  {                                                                                        \
    _Pragma("unroll") for (int i = 0; i < 8; ++i) ra[i] = *(const u32x4*)(ag + (size_t)i * 32 * K + (KT) * 64); \
    _Pragma("unroll") for (int i = 0; i < 4; ++i) rw[i] = *(const u32x4*)(wg + (size_t)i * 32 * K + (KT) * 64); \
  }
#define GEMM_LS()                                                                          \
  {                                                                                        \
    _Pragma("unroll") for (int i = 0; i < 8; ++i) *(u32x4*)(sA + ((EPI != 1) ? ldsa[i] : lds_w + i * 4096)) = ra[i]; \
    _Pragma("unroll") for (int i = 0; i < 4; ++i) *(u32x4*)(sW + lds_w + i * 4096) = rw[i]; \
  }
#define GEMM_COMPUTE()                                                                     \
  {                                                                                        \
    _Pragma("unroll") for (int kk = 0; kk < 4; ++kk) {                                     \
      bf16x8 fa[4], fw[2];                                                                 \
      const int sw = (((2 * kk + hh) ^ ((r >> 1) & 7)) << 4);                              \
      _Pragma("unroll") for (int mt = 0; mt < 4; ++mt)                                     \
        fa[mt] = *(const bf16x8*)(sA + (wm * 128 + mt * 32 + r) * 128 + sw);               \
      _Pragma("unroll") for (int nt = 0; nt < 2; ++nt)                                     \
        fw[nt] = *(const bf16x8*)(sW + (wn * 64 + nt * 32 + r) * 128 + sw);                \
      _Pragma("unroll") for (int nt = 0; nt < 2; ++nt)                                     \
        _Pragma("unroll") for (int mt = 0; mt < 4; ++mt)                                   \
          acc[nt][mt] = (EPI == 1) ? MFMA(fa[mt], fw[nt], acc[nt][mt]) : MFMA(fw[nt], fa[mt], acc[nt][mt]); \
    }                                                                                      \
  }

template <int EPI>
DI void gemm_tile(const Params& p, const bfu* __restrict__ A, const bfu* __restrict__ W, int m0, int n0, char* smem,
                  int layer, const float* __restrict__ resid) {
  constexpr int K = 1024;
  const int tid = tid_l(), lane = tid & 63, w = tid >> 6, r = lane & 31, hh = lane >> 5;
  const int wm = w & 1, wn = w >> 1;
  const int lrow = tid >> 3, lc = tid & 7;
  const bfu* ag = A + (size_t)(m0 + lrow) * K + lc * 8;
  const bfu* wg = W + (size_t)(n0 + lrow) * K + lc * 8;
  const int lds_w = lrow * 128 + ((lc ^ ((lrow >> 1) & 7)) << 4);
  int ldsa[8];
#pragma unroll
  for (int i = 0; i < 8; ++i) {
    const int prow = (i >> 2) * 128 + (2 * ((i & 3) >> 1) + (lrow & 1)) * 32 + (lrow >> 1) + 16 * (i & 1);
    ldsa[i] = prow * 128 + ((lc ^ ((prow >> 1) & 7)) << 4);
  }
#define GTOK(mt) (mw + 64 * ((mt) >> 1) + ((mt) & 1) + 2 * r)
  char* sA = smem;
  char* sW = smem + 32768;
  u32x4 ra[8], rw[4];
  GEMM_GL(0);
  float gate[2];
  if (EPI == 1) {
    const float* mf = (const float*)(p.ws + OFF_MODF) + (size_t)(layer * 4 + (m0 >> 12)) * 3072 + 2048 + n0 + wn * 64 + r;
    gate[0] = mf[0];
    gate[1] = mf[32];
  }
  f32x16 acc[2][4];
#pragma unroll
  for (int a = 0; a < 2; ++a)
#pragma unroll
    for (int b2 = 0; b2 < 4; ++b2)
#pragma unroll
      for (int i = 0; i < 16; ++i) acc[a][b2][i] = 0.f;
  GEMM_LS();
  __syncthreads();
#pragma unroll 1
  for (int kt = 0; kt < 16; ++kt) {
    const int kn = (kt + 1 < 16) ? kt + 1 : 15;
    GEMM_GL(kn);
    __builtin_amdgcn_sched_barrier(0);
    GEMM_COMPUTE();
    __syncthreads();
    GEMM_LS();
    __syncthreads();
  }

  const int nb = n0 + wn * 64;
  const int b = m0 >> 12;
  const int mw = m0 + wm * 128;
  bfu* proj = (bfu*)(p.ws + OFF_PROJ);
  if (EPI == 1) {
#pragma unroll
    for (int mt = 0; mt < 4; ++mt)
#pragma unroll
      for (int i = 0; i < 16; ++i) {
        const int token = mw + mt * 32 + crow(i, hh);
        const size_t off = (size_t)token * 1024 + nb + r;
        if (layer == 0) {
          const float r0 = resid[off], r1 = resid[off + 32];
          bfu* x1b = (bfu*)(p.ws + OFF_X1B);
          x1b[off] = f2bf(r0 + gate[0] * acc[0][mt][i]);
          x1b[off + 32] = f2bf(r1 + gate[1] * acc[1][mt][i]);
        } else {
          const bfu* x1b = (const bfu*)(p.ws + OFF_X1B);
          const float r0 = bf2f(x1b[off]), r1 = bf2f(x1b[off + 32]);
          __builtin_nontemporal_store(r0 + gate[0] * acc[0][mt][i], p.out + off);
          __builtin_nontemporal_store(r1 + gate[1] * acc[1][mt][i], p.out + off + 32);
        }
      }
  } else if (EPI == 0) {
    if (nb < 1024) {
      const bool isk = nb >= 512;
      const float* gg = isk ? p.a_k_g : p.a_q_g;
      float gv[2][16], cs[2][16];
#pragma unroll
      for (int nt = 0; nt < 2; ++nt)
#pragma unroll
        for (int i = 0; i < 16; ++i) { gv[nt][i] = gg[nt * 32 + crow(i, hh)]; cs[nt][i] = 0.f; }
#pragma unroll
      for (int mt = 0; mt < 4; ++mt) {
        float ss = 0.f;
#pragma unroll
        for (int nt = 0; nt < 2; ++nt)
#pragma unroll
          for (int i = 0; i < 16; ++i) ss += acc[nt][mt][i] * acc[nt][mt][i];
        ss += __shfl_xor(ss, 32);
        const float rstd = rsqrtf(ss * (1.f / 64.f) + 1e-6f);
        const int token = GTOK(mt);
        bfu* dst = proj + (size_t)token * 3072 + nb;
#pragma unroll
        for (int nt = 0; nt < 2; ++nt) {
          u32x2 ob[4];
#pragma unroll
          for (int g4 = 0; g4 < 4; ++g4) {
            float v[4];
#pragma unroll
            for (int q = 0; q < 4; ++q) {
              v[q] = acc[nt][mt][4 * g4 + q] * rstd * gv[nt][4 * g4 + q];
              cs[nt][4 * g4 + q] += v[q];
            }
            ob[g4][0] = pack2(v[0], v[1]); ob[g4][1] = pack2(v[2], v[3]);
          }
          store_pair16(dst + nt * 32, ob[0], ob[1], hh);
          store_pair16(dst + nt * 32 + 16, ob[2], ob[3], hh);
        }
      }
      if (isk) {
        const int head = (nb - 512) >> 6;
        const int tokblk = (mw & 4095) >> 7;
        float* ks = (float*)(p.ws + OFF_KSUM) + (size_t)((b * 8 + head) * 32 + tokblk) * 64;
#pragma unroll
        for (int nt = 0; nt < 2; ++nt)
#pragma unroll
          for (int i = 0; i < 16; ++i) {
            float v = cs[nt][i];
#pragma unroll
            for (int off = 1; off < 32; off <<= 1) v += __shfl_xor(v, off);
            if (r == 0) ks[nt * 32 + crow(i, hh)] = v;
          }
      }
    } else if (nb < 1536) {
      const int head = (nb - 1024) >> 6;
      bfu* vt = (bfu*)(p.ws + OFF_VT) + (size_t)((b * 8 + head) * 64) * 4096;
#pragma unroll
      for (int nt = 0; nt < 2; ++nt)
#pragma unroll
        for (int a = 0; a < 2; ++a) {
          const int s0 = (mw & 4095) + 64 * a + 2 * r;
#pragma unroll
          for (int i = 0; i < 16; ++i)
            *(unsigned*)(vt + (size_t)(nt * 32 + crow(i, hh)) * 4096 + s0) = pack2(acc[nt][2 * a][i], acc[nt][2 * a + 1][i]);
        }
    } else {
      const bool act = (nb < 2048) || (nb >= 2560);
#pragma unroll
      for (int nt = 0; nt < 2; ++nt)
#pragma unroll
        for (int mt = 0; mt < 4; ++mt) {
          const int token = GTOK(mt);
          bfu* dst = proj + (size_t)token * 3072 + nb + nt * 32;
          u32x2 ob[4];
#pragma unroll
          for (int g4 = 0; g4 < 4; ++g4) {
            float v[4];
#pragma unroll
            for (int q = 0; q < 4; ++q) { v[q] = acc[nt][mt][4 * g4 + q]; if (act) v[q] = silu_f(v[q]); }
            ob[g4][0] = pack2(v[0], v[1]); ob[g4][1] = pack2(v[2], v[3]);
          }
          store_pair16(dst, ob[0], ob[1], hh);
          store_pair16(dst + 16, ob[2], ob[3], hh);
        }
    }
  } else {
    if (nb >= 1024 && nb < 2048) {
      const int c0 = nb - 1024;
      bfu* gvt = (bfu*)(p.ws + OFF_GVT) + (size_t)(b * 1024 + c0) * 4096;
      float* stats = (float*)(p.ws + OFF_STATS);
#pragma unroll
      for (int mt = 0; mt < 4; ++mt) {
        const int token = GTOK(mt);
        float s1 = 0.f, s2 = 0.f;
#pragma unroll
        for (int nt = 0; nt < 2; ++nt)
#pragma unroll
          for (int i = 0; i < 16; ++i) {
            const float v = gelu_f(acc[nt][mt][i]);
            s1 += v; s2 += v * v;
            acc[nt][mt][i] = v;
          }
        s1 += __shfl_xor(s1, 32);
        s2 += __shfl_xor(s2, 32);
        if (hh == 0) {
          float2 o; o.x = s1; o.y = s2;
          *(float2*)(stats + ((size_t)token * 16 + (c0 >> 6)) * 2) = o;
        }
      }
#pragma unroll
      for (int nt = 0; nt < 2; ++nt)
#pragma unroll
        for (int a = 0; a < 2; ++a) {
          const int s0 = (mw & 4095) + 64 * a + 2 * r;
#pragma unroll
          for (int i = 0; i < 16; ++i)
            *(unsigned*)(gvt + (size_t)(nt * 32 + crow(i, hh)) * 4096 + s0) = pack2(acc[nt][2 * a][i], acc[nt][2 * a + 1][i]);
        }
    } else {
      const bool isu = nb < 1024;
#pragma unroll
      for (int nt = 0; nt < 2; ++nt)
#pragma unroll
        for (int mt = 0; mt < 4; ++mt) {
          const int token = GTOK(mt);
          bfu* dst = proj + (size_t)token * 3072 + nb + nt * 32;
          u32x2 ob[4];
#pragma unroll
          for (int g4 = 0; g4 < 4; ++g4) {
            float v[4];
#pragma unroll
            for (int q = 0; q < 4; ++q) { const float a = acc[nt][mt][4 * g4 + q]; v[q] = isu ? gelu_f(a) : silu_f(a); }
            ob[g4][0] = pack2(v[0], v[1]); ob[g4][1] = pack2(v[2], v[3]);
          }
          store_pair16(dst, ob[0], ob[1], hh);
          store_pair16(dst + 16, ob[2], ob[3], hh);
        }
    }
  }
}

#undef GTOK
DI void mlstm_prep_item(const Params& p, int it, char* smem) {
  const int tid = tid_l(), lane = tid & 63, w = __builtin_amdgcn_readfirstlane(tid >> 6), r = lane & 31, hh = lane >> 5;
  const int b = it >> 6, c = it & 63;
  const int tok0 = b * 4096 + c * 64;
  const bfu* proj = (const bfu*)(p.ws + OFF_PROJ);
  bfu* qm = (bfu*)(p.ws + OFF_QM);
  bfu* km = (bfu*)(p.ws + OFF_KM);
  bfu* vm = (bfu*)(p.ws + OFF_VM);
  bfu* xcb = (bfu*)(p.ws + OFF_XC);
  bfu* ktm = (bfu*)(p.ws + OFF_KT);
  float* sG = (float*)smem;
  float* sWt = (float*)(smem + 8192);
  {
    const int blk = tid & 127, th = tid >> 7;
    const int ch = blk * 4;
    float cw[4][4], cb[4], q_w[4][4], k_w[4][4], v_w[4][4];
#pragma unroll
    for (int j = 0; j < 4; ++j)
#pragma unroll
      for (int i = 0; i < 4; ++i) {
        cw[j][i] = p.conv_w[j * 512 + ch + i];
        q_w[j][i] = p.wq[blk * 16 + j * 4 + i];
        k_w[j][i] = p.wk[blk * 16 + j * 4 + i];
        v_w[j][i] = p.wv[blk * 16 + j * 4 + i];
      }
#pragma unroll
    for (int i = 0; i < 4; ++i) cb[i] = p.conv_b[ch + i];
    float win[4][4];
    const int sl0 = c * 64 + th * 32;
#pragma unroll
    for (int j = 0; j < 3; ++j) {
      const int sp = sl0 - 3 + j;
      if (sp >= 0) {
        const u32x2 v = *(const u32x2*)(proj + (size_t)(b * 4096 + sp) * 3072 + 2048 + ch);
        win[j][0] = bflo(v[0]); win[j][1] = bfhi(v[0]); win[j][2] = bflo(v[1]); win[j][3] = bfhi(v[1]);
      } else {
        win[j][0] = win[j][1] = win[j][2] = win[j][3] = 0.f;
      }
    }
    const float kscale = 0.08838834764831845f;
    const bfu* bxp = proj + ((size_t)b * 4096 + sl0) * 3072 + 2048 + ch;
    u32x2 cur[8], nxt[8];
    float kk8[4][8], vv8[4][8];
#pragma unroll
    for (int q = 0; q < 8; ++q) cur[q] = *(const u32x2*)(bxp + (size_t)q * 3072);
#pragma unroll 1
    for (int t8 = 0; t8 < 4; ++t8) {
      const int tn = (t8 < 3) ? (t8 + 1) * 8 : 24;
#pragma unroll
      for (int q = 0; q < 8; ++q) nxt[q] = *(const u32x2*)(bxp + (size_t)(tn + q) * 3072);
      __builtin_amdgcn_sched_barrier(0);
#pragma unroll
      for (int q = 0; q < 8; ++q) {
        const size_t token = (size_t)b * 4096 + sl0 + t8 * 8 + q;
        const u32x2 v = cur[q];
        win[3][0] = bflo(v[0]); win[3][1] = bfhi(v[0]); win[3][2] = bflo(v[1]); win[3][3] = bfhi(v[1]);
        float xc[4], bq[4], bk[4], bv[4];
#pragma unroll
        for (int i = 0; i < 4; ++i) {
          float a = cb[i];
#pragma unroll
          for (int j = 0; j < 4; ++j) a += cw[j][i] * win[j][i];
          xc[i] = silu_f(a);
        }
#pragma unroll
        for (int o = 0; o < 4; ++o) {
          float aq = 0.f, ak = 0.f, av = 0.f;
#pragma unroll
          for (int i = 0; i < 4; ++i) { aq += xc[i] * q_w[i][o]; ak += xc[i] * k_w[i][o]; av += win[3][i] * v_w[i][o]; }
          bq[o] = aq; bk[o] = ak * kscale; bv[o] = av;
        }
        u32x2 o;
        o[0] = pack2(bq[0], bq[1]); o[1] = pack2(bq[2], bq[3]); *(u32x2*)(qm + token * 512 + ch) = o;
        o[0] = pack2(bk[0], bk[1]); o[1] = pack2(bk[2], bk[3]); *(u32x2*)(km + token * 512 + ch) = o;
#pragma unroll
        for (int o4 = 0; o4 < 4; ++o4) { kk8[o4][q] = bk[o4]; vv8[o4][q] = bv[o4]; }
        o[0] = pack2(xc[0], xc[1]); o[1] = pack2(xc[2], xc[3]); *(u32x2*)(xcb + token * 512 + ch) = o;
#pragma unroll
        for (int j = 0; j < 3; ++j)
#pragma unroll
          for (int i = 0; i < 4; ++i) win[j][i] = win[j + 1][i];
      }
#pragma unroll
      for (int o4 = 0; o4 < 4; ++o4) {
        const size_t off = ((size_t)((b * 4 + (blk >> 5)) * 64 + c) * 128 + (blk & 31) * 4 + o4) * 64 + th * 32 + t8 * 8;
        u32x4 pk = {pack2(kk8[o4][0], kk8[o4][1]), pack2(kk8[o4][2], kk8[o4][3]), pack2(kk8[o4][4], kk8[o4][5]), pack2(kk8[o4][6], kk8[o4][7])};
        *(u32x4*)(ktm + off) = pk;
        u32x4 pv = {pack2(vv8[o4][0], vv8[o4][1]), pack2(vv8[o4][2], vv8[o4][3]), pack2(vv8[o4][4], vv8[o4][5]), pack2(vv8[o4][6], vv8[o4][7])};
        *(u32x4*)(vm + off) = pv;
      }
#pragma unroll
      for (int q = 0; q < 8; ++q) cur[q] = nxt[q];
    }
  }
  __threadfence_block();
  __syncthreads();
  {
    const bfu* gt = (const bfu*)(p.ws + OFF_GT);
    f32x16 acc[2];
#pragma unroll
    for (int tt = 0; tt < 2; ++tt)
#pragma unroll
      for (int i = 0; i < 16; ++i) acc[tt][i] = 0.f;
#pragma unroll 4
    for (int ksi = 0; ksi < 16; ++ksi) {
      const int ch = (16 * w + ksi) * 16 + 8 * hh;
      const bf16x8 af = as_frag(*(const u32x4*)(gt + r * 1024 + ch));
#pragma unroll
      for (int tt = 0; tt < 2; ++tt) {
        const size_t token = (size_t)tok0 + 32 * tt + r;
        const bfu* src = (ch < 512) ? (xcb + token * 512 + ch) : (proj + token * 3072 + 2048 + (ch - 512));
        const bf16x8 bfr = as_frag(*(const u32x4*)src);
        acc[tt] = MFMA(af, bfr, acc[tt]);
      }
    }
#pragma unroll
    for (int tt = 0; tt < 2; ++tt)
#pragma unroll
      for (int i = 0; i < 4; ++i) sG[(w * 8 + 4 * hh + i) * 64 + 32 * tt + r] = acc[tt][i];
  }
  __syncthreads();
  {
    const int head = w, tok = lane;
    float ig = p.b_gates[head], fg = p.b_gates[4 + head];
#pragma unroll
    for (int ww = 0; ww < 4; ++ww) { ig += sG[(ww * 8 + head) * 64 + tok]; fg += sG[(ww * 8 + 4 + head) * 64 + tok]; }
    const float lf = fminf(fg, 0.f) - log1pf(__expf(-fabsf(fg)));
    float cum = lf;
#pragma unroll
    for (int off = 1; off < 64; off <<= 1) {
      const float o = __shfl_up(cum, off);
      if (lane >= off) cum += o;
    }
    const float tot = __shfl(cum, 63);
    const float a = ig - cum;
    const int bh = b * 4 + head;
    ((float*)(p.ws + OFF_CUM))[(size_t)bh * 4096 + c * 64 + tok] = cum;
    ((float*)(p.ws + OFF_AG))[(size_t)bh * 4096 + c * 64 + tok] = a;
    if (lane == 0) ((float*)(p.ws + OFF_TOT))[bh * 64 + c] = tot;
    sWt[head * 64 + tok] = __expf(tot + a);
  }
  __syncthreads();
  {
    const int h = w;
    const int bh = b * 4 + h;
    const bfu* ktc = ktm + (size_t)(bh * 64 + c) * 128 * 64;
    const bfu* vtc = vm + (size_t)(bh * 64 + c) * 128 * 64;
    bfu* ust = (bfu*)(p.ws + OFF_UST) + (size_t)(bh * 64 + c) * 129 * 128;
    float wsr[4][8];
#pragma unroll
    for (int ss = 0; ss < 4; ++ss)
#pragma unroll
      for (int j = 0; j < 8; ++j) wsr[ss][j] = sWt[h * 64 + 16 * ss + 8 * hh + j];
    u32x4 vall[4][4];
#pragma unroll
    for (int vt = 0; vt < 4; ++vt)
#pragma unroll
      for (int ss = 0; ss < 4; ++ss) vall[vt][ss] = *(const u32x4*)(vtc + (size_t)(vt * 32 + r) * 64 + 16 * ss + 8 * hh);
    bf16x8 kall[4][4];
#pragma unroll
    for (int kt = 0; kt < 4; ++kt)
#pragma unroll
      for (int ss = 0; ss < 4; ++ss) kall[kt][ss] = as_frag(*(const u32x4*)(ktc + (size_t)(kt * 32 + r) * 64 + 16 * ss + 8 * hh));
#pragma unroll
    for (int vt = 0; vt < 5; ++vt) {
      bf16x8 vf[4];
#pragma unroll
      for (int ss = 0; ss < 4; ++ss) {
        float f[8];
        if (vt < 4) {
#pragma unroll
          for (int q = 0; q < 4; ++q) { f[2 * q] = bflo(vall[vt < 4 ? vt : 0][ss][q]) * wsr[ss][2 * q]; f[2 * q + 1] = bfhi(vall[vt < 4 ? vt : 0][ss][q]) * wsr[ss][2 * q + 1]; }
        } else {
#pragma unroll
          for (int j = 0; j < 8; ++j) f[j] = (r == 0) ? wsr[ss][j] : 0.f;
        }
        u32x4 pk = {pack2(f[0], f[1]), pack2(f[2], f[3]), pack2(f[4], f[5]), pack2(f[6], f[7])};
        vf[ss] = as_frag(pk);
      }
#pragma unroll
      for (int kp = 0; kp < 2; ++kp) {
        f32x16 acc[2];
#pragma unroll
        for (int kt = 0; kt < 2; ++kt)
#pragma unroll
          for (int i = 0; i < 16; ++i) acc[kt][i] = 0.f;
#pragma unroll
        for (int ss = 0; ss < 4; ++ss)
#pragma unroll
          for (int kt = 0; kt < 2; ++kt) acc[kt] = MFMA(kall[kp * 2 + kt][ss], vf[ss], acc[kt]);
#pragma unroll
        for (int kt = 0; kt < 2; ++kt)
#pragma unroll
          for (int gp = 0; gp < 2; ++gp) {
            u32x2 oa = {pack2(acc[kt][8 * gp], acc[kt][8 * gp + 1]), pack2(acc[kt][8 * gp + 2], acc[kt][8 * gp + 3])};
            u32x2 obb = {pack2(acc[kt][8 * gp + 4], acc[kt][8 * gp + 5]), pack2(acc[kt][8 * gp + 6], acc[kt][8 * gp + 7])};
            const auto s0 = __builtin_amdgcn_permlane32_swap(oa[0], obb[0], false, false);
            const auto s1 = __builtin_amdgcn_permlane32_swap(oa[1], obb[1], false, false);
            u32x4 o = {s0[0], s1[0], s0[1], s1[1]};
            if (vt < 4 || r == 0) *(u32x4*)(ust + (size_t)(vt * 32 + r) * 128 + (kp * 2 + kt) * 32 + 16 * gp + 8 * hh) = o;
          }
      }
    }
  }
  __syncthreads();
}

DI void scan_item(const Params& p, int it) {
  const int id = it * 256 + tid_l();
  const int bh = id / 2064, e8 = id % 2064;
  bfu* base = (bfu*)(p.ws + OFF_UST) + (size_t)bh * 64 * 16512 + e8 * 8;
  const float* tot = (const float*)(p.ws + OFF_TOT) + bh * 64;
  float st[8];
#pragma unroll
  for (int j = 0; j < 8; ++j) st[j] = 0.f;
  for (int c0 = 0; c0 < 64; c0 += 8) {
    u32x4 u[8];
#pragma unroll
    for (int j = 0; j < 8; ++j) u[j] = *(const u32x4*)(base + (size_t)(c0 + j) * 16512);
#pragma unroll
    for (int j = 0; j < 8; ++j) {
      u32x4 o = {pack2(st[0], st[1]), pack2(st[2], st[3]), pack2(st[4], st[5]), pack2(st[6], st[7])};
      *(u32x4*)(base + (size_t)(c0 + j) * 16512) = o;
      const float dec = __expf(tot[c0 + j]);
#pragma unroll
      for (int q = 0; q < 4; ++q) {
        st[2 * q] = dec * st[2 * q] + bflo(u[j][q]);
        st[2 * q + 1] = dec * st[2 * q + 1] + bfhi(u[j][q]);
      }
    }
  }
}

DI void moba_item(const Params& p, int mi, char* smem) {
  const int tid = tid_l(), lane = tid & 63, w = tid >> 6, r = lane & 31, hh = lane >> 5;
  const int jb = 15 - (mi >> 6);
  const int rem = mi & 63;
  const int half = 1 - (rem >> 5);
  const int bh = rem & 31;
  const int b = bh >> 3, h = bh & 7;
  const int q0 = jb * 256 + half * 128;
  const size_t tokbase = (size_t)b * 4096;
  const bfu* proj = (const bfu*)(p.ws + OFF_PROJ);
  const bfu* vtg = (const bfu*)(p.ws + OFF_VT) + (size_t)bh * 64 * 4096;
  float* sKM = (float*)smem;
  char* sK = smem + 4096;
  char* sV = smem + 4096 + 24576;
  {
    const float* ks = (const float*)(p.ws + OFF_KSUM) + (size_t)bh * 32 * 64;
    for (int idx = tid; idx < jb * 64; idx += 256) {
      const int n = idx >> 6, d = idx & 63;
      const float* q2 = ks + (size_t)(2 * n) * 64 + d;
      sKM[idx] = q2[0] + q2[64];
    }
  }
  const int qpos = q0 + w * 32 + r;
  const size_t qtoken = tokbase + qpos;
  u32x4 qf[4];
#pragma unroll
  for (int kk = 0; kk < 4; ++kk) qf[kk] = *(const u32x4*)(proj + qtoken * 3072 + h * 64 + kk * 16 + hh * 8);
  __syncthreads();
  unsigned sel;
  {
    float s1 = -INFINITY, s2 = -INFINITY, s3 = -INFINITY;
    int i1 = -1, i2 = -1, i3 = -1;
    for (int n = 0; n < jb; ++n) {
      float dot = 0.f;
#pragma unroll
      for (int kk = 0; kk < 4; ++kk) {
        const float* km = sKM + n * 64 + kk * 16 + hh * 8;
#pragma unroll
        for (int e = 0; e < 4; ++e) {
          dot += bflo(qf[kk][e]) * km[2 * e];
          dot += bfhi(qf[kk][e]) * km[2 * e + 1];
        }
      }
      dot += __shfl_xor(dot, 32);
      if (dot > s1) { s3 = s2; i3 = i2; s2 = s1; i2 = i1; s1 = dot; i1 = n; }
      else if (dot > s2) { s3 = s2; i3 = i2; s2 = dot; i2 = n; }
      else if (dot > s3) { s3 = dot; i3 = n; }
    }
    if (jb <= 3) sel = (1u << jb) - 1u;
    else sel = (1u << i1) | (1u << i2) | (1u << i3);
  }
  const int ntile = 4 * jb + (half ? 4 : 2);
  const int lrow = tid >> 3, lch = tid & 7;
  u32x4 kregA[2], vregA[2], kregB[2], vregB[2];
  auto gload = [&](int tix, u32x4 (&kreg)[2], u32x4 (&vreg)[2]) {
    const int n = tix >> 2, tk = tix & 3;
    const int key0 = n * 256 + tk * 64;
#pragma unroll
    for (int i = 0; i < 2; ++i) {
      const int row = lrow + 32 * i;
      kreg[i] = *(const u32x4*)(proj + (tokbase + key0 + row) * 3072 + 512 + h * 64 + lch * 8);
      vreg[i] = *(const u32x4*)(vtg + (size_t)row * 4096 + key0 + lch * 8);
    }
  };
  auto lstore = [&](int buf, u32x4 (&kreg)[2], u32x4 (&vreg)[2]) {
#pragma unroll
    for (int i = 0; i < 2; ++i) {
      const int row = lrow + 32 * i;
      const int sw = (row >> 1) & 7;
      *(u32x4*)(sK + buf * 8192 + row * 128 + ((lch ^ sw) << 4)) = kreg[i];
      const int g = lch >> 1, hf = (lch & 1) << 3;
      u32x2 lo = {vreg[i][0], vreg[i][1]}, hi = {vreg[i][2], vreg[i][3]};
      *(u32x2*)(sV + buf * 8192 + row * 128 + (((2 * g) ^ sw) << 4) + hf) = lo;
      *(u32x2*)(sV + buf * 8192 + row * 128 + (((2 * g + 1) ^ sw) << 4) + hf) = hi;
    }
  };
  const f32x16 zero16 = {0.f, 0.f, 0.f, 0.f, 0.f, 0.f, 0.f, 0.f, 0.f, 0.f, 0.f, 0.f, 0.f, 0.f, 0.f, 0.f};
  const int qmax = q0 + w * 32 + 31;
  int lofs[4];
#pragma unroll
  for (int g = 0; g < 4; ++g) lofs[g] = r * 128 + (((2 * g + hh) ^ ((r >> 1) & 7)) << 4);
  auto compute_s = [&](int tix, int buf, f32x16 (&s)[2]) {
    const int key0 = (tix >> 2) * 256 + (tix & 3) * 64;
    if (key0 <= qmax) {
      const char* kb = sK + buf * 8192;
      const bool two = (key0 + 32 <= qmax);
      if ((tix >> 2) == jb) {
        const int lim = qpos - key0 - 4 * hh;
        f32x16 b0, b1;
#pragma unroll
        for (int i = 0; i < 16; ++i) {
          const int cidx = (i & 3) + 8 * (i >> 2);
          b0[i] = (cidx <= lim) ? 0.f : -INFINITY;
          b1[i] = (two && (32 + cidx <= lim)) ? 0.f : -INFINITY;
        }
        s[0] = MFMA(*(const bf16x8*)(kb + lofs[0]), as_frag(qf[0]), b0);
#pragma unroll
        for (int kk = 1; kk < 4; ++kk) s[0] = MFMA(*(const bf16x8*)(kb + lofs[kk]), as_frag(qf[kk]), s[0]);
        if (two) {
          s[1] = MFMA(*(const bf16x8*)(kb + 4096 + lofs[0]), as_frag(qf[0]), b1);
#pragma unroll
          for (int kk = 1; kk < 4; ++kk) s[1] = MFMA(*(const bf16x8*)(kb + 4096 + lofs[kk]), as_frag(qf[kk]), s[1]);
        } else {
          s[1] = b1;
        }
      } else {
        s[0] = MFMA(*(const bf16x8*)(kb + lofs[0]), as_frag(qf[0]), zero16);
#pragma unroll
        for (int kk = 1; kk < 4; ++kk) s[0] = MFMA(*(const bf16x8*)(kb + lofs[kk]), as_frag(qf[kk]), s[0]);
        s[1] = MFMA(*(const bf16x8*)(kb + 4096 + lofs[0]), as_frag(qf[0]), zero16);
#pragma unroll
        for (int kk = 1; kk < 4; ++kk) s[1] = MFMA(*(const bf16x8*)(kb + 4096 + lofs[kk]), as_frag(qf[kk]), s[1]);
      }
    }
  };
  f32x16 oacc[2];
#pragma unroll
  for (int dt = 0; dt < 2; ++dt)
#pragma unroll
    for (int i = 0; i < 16; ++i) oacc[dt][i] = 0.f;
  float mrun = -1e30f;
  f32x16 lacc = zero16;
  const unsigned onev = (r == 0) ? 0x3F803F80u : 0u;
  const u32x4 ones4 = {onev, onev, onev, onev};
  const bf16x8 onesf = as_frag(ones4);
  const float cs = 0.125f * 1.4426950408889634f;
  auto step = [&](int tix, int b0, int b1, int b2, f32x16 (&scur)[2], f32x16 (&snext)[2], u32x4 (&kreg)[2], u32x4 (&vreg)[2]) {
    if (tix + 1 < ntile) compute_s(tix + 1, b1, snext);
    const int n = tix >> 2, tk = tix & 3;
    const int key0 = n * 256 + tk * 64;
    if (key0 <= qmax) {
      const char* vb = sV + b0 * 8192;
      const bool own = (n == jb);
      const bool lsel = own || ((sel >> n) & 1u);
      const bool act1 = (key0 + 32 <= qmax);
      float mt = scur[0][0];
#pragma unroll
      for (int i = 1; i < 16; ++i) mt = fmaxf(mt, scur[0][i]);
#pragma unroll
      for (int i = 0; i < 16; ++i) mt = fmaxf(mt, scur[1][i]);
      mt = fmaxf(mt, __shfl_xor(mt, 32));
      mt = lsel ? mt : -INFINITY;
      const float mnew = fmaxf(mrun, mt);
      const float alpha = __builtin_amdgcn_exp2f((mrun - mnew) * cs);
      mrun = mnew;
      const float nbias = (lsel && mnew > -1e29f) ? -mnew * cs : -INFINITY;
#pragma unroll
      for (int kt = 0; kt < 2; ++kt)
#pragma unroll
        for (int i = 0; i < 16; ++i) scur[kt][i] = __builtin_amdgcn_exp2f(__builtin_fmaf(scur[kt][i], cs, nbias));
      lacc[0] *= alpha;
#pragma unroll
      for (int dt = 0; dt < 2; ++dt)
#pragma unroll
        for (int i = 0; i < 16; ++i) oacc[dt][i] *= alpha;
#pragma unroll
      for (int kt = 0; kt < 2; ++kt) {
        if (kt == 0 || act1) {
#pragma unroll
          for (int ss = 0; ss < 2; ++ss) {
            u32x4 pk = {pack2(scur[kt][8 * ss], scur[kt][8 * ss + 1]), pack2(scur[kt][8 * ss + 2], scur[kt][8 * ss + 3]),
                        pack2(scur[kt][8 * ss + 4], scur[kt][8 * ss + 5]), pack2(scur[kt][8 * ss + 6], scur[kt][8 * ss + 7])};
            const bf16x8 pf = as_frag(pk);
#pragma unroll
            for (int dt = 0; dt < 2; ++dt) {
              const bf16x8 vf = *(const bf16x8*)(vb + dt * 4096 + lofs[2 * kt + ss]);
              oacc[dt] = MFMA(vf, pf, oacc[dt]);
            }
            lacc = MFMA(onesf, pf, lacc);
          }
        }
      }
    }
    lstore(b2, kreg, vreg);
    gload((tix + 4 < ntile) ? tix + 4 : ntile - 1, kreg, vreg);
    __syncthreads();
  };
  gload(0, kregA, vregA);
  gload(1, kregB, vregB);
  lstore(0, kregA, vregA);
  gload((2 < ntile) ? 2 : ntile - 1, kregA, vregA);
  lstore(1, kregB, vregB);
  gload((3 < ntile) ? 3 : ntile - 1, kregB, vregB);
  __syncthreads();
  f32x16 sa[2], sb[2];
  sa[0] = zero16; sa[1] = zero16; sb[0] = zero16; sb[1] = zero16;
  compute_s(0, 0, sa);
  {
    int b0 = 0;
#pragma unroll 1
    for (int tix = 0; tix < ntile; tix += 2) {
      const int b1 = (b0 == 2) ? 0 : b0 + 1;
      const int b2 = (b1 == 2) ? 0 : b1 + 1;
      step(tix, b0, b1, b2, sa, sb, kregA, vregA);
      if (tix + 1 < ntile) step(tix + 1, b1, b2, b0, sb, sa, kregB, vregB);
      b0 = b2;
    }
  }
  {
    const float ltot = __shfl(lacc[0], r);
    const float inv = 1.f / ltot;
    bfu* ym = (bfu*)(p.ws + OFF_HBUF);
#pragma unroll
    for (int dt = 0; dt < 2; ++dt) {
      u32x2 ob[4], azp[4];
      load_pair16(proj + qtoken * 3072 + 1536 + h * 64 + dt * 32, hh, azp[0], azp[1]);
      load_pair16(proj + qtoken * 3072 + 1536 + h * 64 + dt * 32 + 16, hh, azp[2], azp[3]);
#pragma unroll
      for (int g4 = 0; g4 < 4; ++g4) {
        const u32x2 az = azp[g4];
        const float y0 = oacc[dt][4 * g4] * inv * bflo(az[0]);
        const float y1 = oacc[dt][4 * g4 + 1] * inv * bfhi(az[0]);
        const float y2 = oacc[dt][4 * g4 + 2] * inv * bflo(az[1]);
        const float y3 = oacc[dt][4 * g4 + 3] * inv * bfhi(az[1]);
        ob[g4][0] = pack2(y0, y1); ob[g4][1] = pack2(y2, y3);
      }
      store_pair16(ym + qtoken * 1024 + h * 64 + dt * 32, ob[0], ob[1], hh);
      store_pair16(ym + qtoken * 1024 + h * 64 + dt * 32 + 16, ob[2], ob[3], hh);
    }
  }
}

DI void mlstm_out_item(const Params& p, int it) {
  const int lane = tid_l() & 63, r = lane & 31, hh = lane >> 5;
  const int bh = it >> 7, c = (it >> 1) & 63, tt = it & 1;
  const int b = bh >> 2, h = bh & 3;
  const size_t tok0 = (size_t)b * 4096 + c * 64;
  const bfu* proj = (const bfu*)(p.ws + OFF_PROJ);
  const bfu* qm = (const bfu*)(p.ws + OFF_QM);
  const bfu* km = (const bfu*)(p.ws + OFF_KM);
  const bfu* vm = (const bfu*)(p.ws + OFF_VM);
  const bfu* xcb = (const bfu*)(p.ws + OFF_XC);
  const bfu* cst = (const bfu*)(p.ws + OFF_UST) + (size_t)(bh * 64 + c) * 129 * 128;
  const float* cumv = (const float*)(p.ws + OFF_CUM) + (size_t)bh * 4096 + c * 64;
  const float* agv = (const float*)(p.ws + OFF_AG) + (size_t)bh * 4096 + c * 64;
  bfu* ym = (bfu*)(p.ws + OFF_HBUF);
  {
    const size_t token = tok0 + 32 * tt + r;
    u32x4 qf[8];
#pragma unroll
    for (int kk = 0; kk < 8; ++kk) qf[kk] = *(const u32x4*)(qm + token * 512 + h * 128 + 16 * kk + 8 * hh);
    const float cum_t = cumv[32 * tt + r];
    const float e_t = __expf(cum_t);
    float dn;
    {
      f32x16 an;
#pragma unroll
      for (int i = 0; i < 16; ++i) an[i] = 0.f;
#pragma unroll
      for (int kk = 0; kk < 8; ++kk) {
        u32x4 cv = {0u, 0u, 0u, 0u};
        if (r == 0) cv = *(const u32x4*)(cst + (size_t)128 * 128 + 16 * kk + 8 * hh);
        an = MFMA(as_frag(cv), as_frag(qf[kk]), an);
      }
      dn = __shfl(an[0], r);
    }
    f32x16 ai[4];
#pragma unroll
    for (int vt = 0; vt < 4; ++vt) {
#pragma unroll
      for (int i = 0; i < 16; ++i) ai[vt][i] = 0.f;
#pragma unroll
      for (int kk = 0; kk < 8; ++kk) {
        const u32x4 cv = *(const u32x4*)(cst + (size_t)(vt * 32 + r) * 128 + 16 * kk + 8 * hh);
        ai[vt] = MFMA(as_frag(cv), as_frag(qf[kk]), ai[vt]);
      }
#pragma unroll
      for (int i = 0; i < 16; ++i) ai[vt][i] *= e_t;
    }
    float den_i = 0.f;
#pragma unroll 1
    for (int st = 0; st <= tt; ++st) {
      f32x16 sacc;
#pragma unroll
      for (int i = 0; i < 16; ++i) sacc[i] = 0.f;
#pragma unroll
      for (int kk = 0; kk < 8; ++kk) {
        const bf16x8 kf = as_frag(*(const u32x4*)(km + (tok0 + 32 * st + r) * 512 + h * 128 + 16 * kk + 8 * hh));
        sacc = MFMA(kf, as_frag(qf[kk]), sacc);
      }
      const int tl = 32 * tt + r;
#pragma unroll
      for (int g4 = 0; g4 < 4; ++g4) {
        const float4 av = *(const float4*)(agv + 32 * st + 8 * g4 + 4 * hh);
        const float aa[4] = {av.x, av.y, av.z, av.w};
#pragma unroll
        for (int q = 0; q < 4; ++q) {
          const int s = 32 * st + 8 * g4 + 4 * hh + q;
          const float wgt = (s <= tl) ? sacc[4 * g4 + q] * __expf(cum_t + aa[q]) : 0.f;
          sacc[4 * g4 + q] = wgt;
          den_i += wgt;
        }
      }
#pragma unroll
      for (int ss = 0; ss < 2; ++ss) {
        u32x4 pk = {pack2(sacc[8 * ss], sacc[8 * ss + 1]), pack2(sacc[8 * ss + 2], sacc[8 * ss + 3]),
                    pack2(sacc[8 * ss + 4], sacc[8 * ss + 5]), pack2(sacc[8 * ss + 6], sacc[8 * ss + 7])};
        const bf16x8 pf = as_frag(pk);
#pragma unroll
        for (int vt = 0; vt < 4; ++vt) {
          const bfu* vp = vm + ((size_t)(bh * 64 + c) * 128 + vt * 32 + r) * 64 + 32 * st + 16 * ss + 4 * hh;
          const u32x2 lo = *(const u32x2*)vp;
          const u32x2 hi = *(const u32x2*)(vp + 8);
          u32x4 vv = {lo[0], lo[1], hi[0], hi[1]};
          ai[vt] = MFMA(as_frag(vv), pf, ai[vt]);
        }
      }
    }
    den_i += __shfl_xor(den_i, 32);
    const float den = den_i + e_t * dn;
    const float inv = 1.f / fmaxf(fabsf(den), 1.f);
    float s1 = 0.f;
#pragma unroll
    for (int vt = 0; vt < 4; ++vt)
#pragma unroll
      for (int i = 0; i < 16; ++i) {
        const float hv = ai[vt][i] * inv;
        ai[vt][i] = hv;
        s1 += hv;
      }
    s1 += __shfl_xor(s1, 32);
    const float mean = s1 * (1.f / 128.f);
    float s2 = 0.f;
#pragma unroll
    for (int vt = 0; vt < 4; ++vt)
#pragma unroll
      for (int i = 0; i < 16; ++i) { const float d = ai[vt][i] - mean; s2 += d * d; }
    s2 += __shfl_xor(s2, 32);
    const float rstd = rsqrtf(s2 * (1.f / 128.f) + 1e-5f);
#pragma unroll
    for (int vt = 0; vt < 4; ++vt) {
      u32x2 ob[4], xvp[4], zvp[4];
#pragma unroll
      for (int gp = 0; gp < 2; ++gp) {
        load_pair16(xcb + token * 512 + h * 128 + 32 * vt + 16 * gp, hh, xvp[2 * gp], xvp[2 * gp + 1]);
        load_pair16(proj + token * 3072 + 2560 + h * 128 + 32 * vt + 16 * gp, hh, zvp[2 * gp], zvp[2 * gp + 1]);
      }
#pragma unroll
      for (int g4 = 0; g4 < 4; ++g4) {
        const int v = 32 * vt + 8 * g4 + 4 * hh;
        const float4 og = *(const float4*)(p.out_g + h * 128 + v);
        const float4 sk = *(const float4*)(p.skip + h * 128 + v);
        const u32x2 xv = xvp[g4];
        const u32x2 zv = zvp[g4];
        const float y0 = ((ai[vt][4 * g4] - mean) * rstd * og.x + sk.x * bflo(xv[0])) * bflo(zv[0]);
        const float y1 = ((ai[vt][4 * g4 + 1] - mean) * rstd * og.y + sk.y * bfhi(xv[0])) * bfhi(zv[0]);
        const float y2 = ((ai[vt][4 * g4 + 2] - mean) * rstd * og.z + sk.z * bflo(xv[1])) * bflo(zv[1]);
        const float y3 = ((ai[vt][4 * g4 + 3] - mean) * rstd * og.w + sk.w * bfhi(xv[1])) * bfhi(zv[1]);
        ob[g4][0] = pack2(y0, y1); ob[g4][1] = pack2(y2, y3);
      }
      store_pair16(ym + token * 1024 + 512 + h * 128 + 32 * vt, ob[0], ob[1], hh);
      store_pair16(ym + token * 1024 + 512 + h * 128 + 32 * vt + 16, ob[2], ob[3], hh);
    }
  }
}

DI void sgu_item(const Params& p, int it, char* smem) {
  const int tid = tid_l(), lane = tid & 63, w = tid >> 6, r = lane & 31, hh = lane >> 5;
  const int g = it & 7, n = (it >> 3) & 31, b = it >> 8;
  const size_t tok0 = (size_t)b * 4096 + n * 128;
  float* sMu = (float*)smem;
  float* sRs = sMu + 128;
  if (tid < 128) {
    const float* st = (const float*)(p.ws + OFF_STATS) + (tok0 + tid) * 32;
    float s1 = 0.f, s2 = 0.f;
#pragma unroll
    for (int q = 0; q < 16; ++q) { s1 += st[2 * q]; s2 += st[2 * q + 1]; }
    const float mean = s1 * (1.f / 1024.f);
    const float var = fmaxf(s2 * (1.f / 1024.f) - mean * mean, 0.f);
    sMu[tid] = mean;
    sRs[tid] = rsqrtf(var + 1e-5f);
  }
  __syncthreads();
  const int cch = g * 128 + w * 32 + r;
  const float lng = p.c_ln_g[cch], lnb = p.c_ln_b[cch];
  const bfu* gvt = (const bfu*)(p.ws + OFF_GVT) + ((size_t)b * 1024 + cch) * 4096 + n * 128;
  const bfu* wsb = (const bfu*)(p.ws + OFF_WSB) + (size_t)g * 128 * 128;
  const bfu* proj = (const bfu*)(p.ws + OFF_PROJ);
  f32x16 acc[4];
#pragma unroll
  for (int tt = 0; tt < 4; ++tt)
#pragma unroll
    for (int i = 0; i < 16; ++i) acc[tt][i] = 0.f;
#pragma unroll
  for (int ks = 0; ks < 8; ++ks) {
    const u32x4 raw = *(const u32x4*)(gvt + 16 * ks + 8 * hh);
    float f[8];
#pragma unroll
    for (int q = 0; q < 4; ++q) { f[2 * q] = bflo(raw[q]); f[2 * q + 1] = bfhi(raw[q]); }
#pragma unroll
    for (int j = 0; j < 8; ++j) {
      const int s = 16 * ks + 8 * hh + j;
      f[j] = (f[j] - sMu[s]) * sRs[s] * lng + lnb;
    }
    u32x4 pk = {pack2(f[0], f[1]), pack2(f[2], f[3]), pack2(f[4], f[5]), pack2(f[6], f[7])};
    const bf16x8 af = as_frag(pk);
#pragma unroll
    for (int tt = 0; tt < 4; ++tt) {
      if (32 * tt + 31 >= 16 * ks) {
        const bf16x8 bfr = as_frag(*(const u32x4*)(wsb + (size_t)(32 * tt + r) * 128 + 16 * ks + 8 * hh));
        acc[tt] = MFMA(af, bfr, acc[tt]);
      }
    }
  }
  bfu* ym = (bfu*)(p.ws + OFF_HBUF);
#pragma unroll
  for (int tt = 0; tt < 4; ++tt) {
    const int t = 32 * tt + r;
    const size_t token = tok0 + t;
    const float bsv = p.c_bs[g * 128 + t];
    u32x2 ob[4], uvp[4], zvp[4];
#pragma unroll
    for (int gp = 0; gp < 2; ++gp) {
      load_pair16(proj + token * 3072 + g * 128 + w * 32 + 16 * gp, hh, uvp[2 * gp], uvp[2 * gp + 1]);
      load_pair16(proj + token * 3072 + 2048 + g * 128 + w * 32 + 16 * gp, hh, zvp[2 * gp], zvp[2 * gp + 1]);
    }
#pragma unroll
    for (int g4 = 0; g4 < 4; ++g4) {
      const u32x2 uv = uvp[g4];
      const u32x2 zv = zvp[g4];
      const float y0 = bflo(uv[0]) * (acc[tt][4 * g4] + bsv) * bflo(zv[0]);
      const float y1 = bfhi(uv[0]) * (acc[tt][4 * g4 + 1] + bsv) * bfhi(zv[0]);
      const float y2 = bflo(uv[1]) * (acc[tt][4 * g4 + 2] + bsv) * bflo(zv[1]);
      const float y3 = bfhi(uv[1]) * (acc[tt][4 * g4 + 3] + bsv) * bfhi(zv[1]);
      ob[g4][0] = pack2(y0, y1); ob[g4][1] = pack2(y2, y3);
    }
    store_pair16(ym + token * 1024 + g * 128 + w * 32, ob[0], ob[1], hh);
    store_pair16(ym + token * 1024 + g * 128 + w * 32 + 16, ob[2], ob[3], hh);
  }
  __syncthreads();
}

#ifndef ONLY_PH
#define ONLY_PH -1
#endif
#define PH_ON(x) (ONLY_PH < 0 || ONLY_PH == (x))
template <int ph>
DI void run_phase(const Params& pin, char* smem, bool rep) {
  const int G = gridDim.x, bid = blockIdx.x;
  if (!PH_ON(ph)) return;
  const Params& p = pin;
  switch (ph) {
    case 0: if (PH_ON(0)) {
      for (int it = bid; it < 1156; it += G) {
        if (it < 384) mod_item(p, it, (float*)smem);
        else if (it < 1152) { const int t = it - 384; transpose_tile(p.w_in, (bfu*)(p.ws + OFF_WTIN), 1024, 3072, (t & 15) * 64, (t >> 4) * 64, (float*)smem); }
        else gt_item(p, it - 1152);
      }
    } break;
    case 1: if (PH_ON(1))
      for (int it = bid; it < 512 + 96; it += G) { if (it < 512) norm_item(p, p.x, 0, it, (float*)smem); else modfin_item(p, it - 512); }
      break;
    case 2: if (PH_ON(2))
      if ((G & 7) == 0) {
        const int x = bid & 7;
        for (int lt = bid >> 3; lt < 192; lt += G >> 3)
          gemm_tile<0>(p, (const bfu*)(p.ws + OFF_HBUF), (const bfu*)(p.ws + OFF_WTIN), (x * 8 + lt / 24) * 256, (lt % 24) * 128, smem, 0, nullptr);
      } else {
        for (int t = bid; t < 64 * 24; t += G)
          gemm_tile<0>(p, (const bfu*)(p.ws + OFF_HBUF), (const bfu*)(p.ws + OFF_WTIN), (t / 24) * 256, (t % 24) * 128, smem, 0, nullptr);
      }
      break;
    case 3: if (PH_ON(3)) {
      const bool split = (G >= 512);
      for (int it = bid; it < 1600; it += (split ? (bid < 256 ? 1600 : G - 256) : G)) {
        if (it < 256) mlstm_prep_item(p, it, smem);
        else if (it < 1024) { const int t = it - 256; transpose_tile(p.w_in + (size_t)1024 * 3072, (bfu*)(p.ws + OFF_WTIN), 1024, 3072, (t & 15) * 64, (t >> 4) * 64, (float*)smem); }
        else if (it < 1280) { const int t = it - 1024; transpose_tile(p.w_out, (bfu*)(p.ws + OFF_WTOUT0), 1024, 1024, (t & 15) * 64, (t >> 4) * 64, (float*)smem); }
        else if (it < 1536) { const int t = it - 1280; transpose_tile(p.w_out + 1024 * 1024, (bfu*)(p.ws + OFF_WTOUT1), 1024, 1024, (t & 15) * 64, (t >> 4) * 64, (float*)smem); }
        else wsb_item(p, it - 1536);
      }
    } break;
    case 4: if (PH_ON(4)) {
      for (int it = bid; it < 129; it += G) { if (!rep) scan_item(p, it); }
      if ((G & 7) == 0) {
        const int x = bid & 7, nl = G >> 3, local = bid >> 3;
        for (int rd = 0; rd * nl < 128; ++rd) {
          const int li = (rd & 1) ? (rd + 1) * nl - 1 - local : rd * nl + local;
          if (li >= 128 || li < 0) continue;
          const int jj = li >> 3, rem = li & 7;
          moba_item(p, (jj << 6) | ((rem >> 2) << 5) | (x * 4 + (rem & 3)), smem);
        }
      } else {
        for (int rd = 0; rd * G < 1024; ++rd) {
          const int pos = (rd & 1) ? (rd + 1) * G - 1 - bid : rd * G + bid;
          if (pos >= 1024) continue;
          moba_item(p, pos, smem);
        }
      }
    } break;
    case 5: if (PH_ON(5)) {
      const int gw = __builtin_amdgcn_readfirstlane(bid * 4 + (tid_l() >> 6));
      for (int it = gw; it < 2048; it += G * 4) mlstm_out_item(p, it);
    } break;
    case 6: if (PH_ON(6))
      if ((G & 7) == 0) {
        const int x = bid & 7;
        for (int lt = bid >> 3; lt < 64; lt += G >> 3)
          gemm_tile<1>(p, (const bfu*)(p.ws + OFF_HBUF), (const bfu*)(p.ws + OFF_WTOUT0), (x * 8 + lt / 8) * 256, (lt % 8) * 128, smem, 0, p.x);
      } else {
        for (int t = bid; t < 64 * 8; t += G)
          gemm_tile<1>(p, (const bfu*)(p.ws + OFF_HBUF), (const bfu*)(p.ws + OFF_WTOUT0), (t / 8) * 256, (t % 8) * 128, smem, 0, p.x);
      }
      break;
    case 7: if (PH_ON(7))
      for (int it = bid; it < 512; it += G) norm_item(p, p.out, 1, it, (float*)smem);
      break;
    case 8: if (PH_ON(8))
      if ((G & 7) == 0) {
        const int x = bid & 7;
        for (int lt = bid >> 3; lt < 192; lt += G >> 3)
          gemm_tile<2>(p, (const bfu*)(p.ws + OFF_HBUF), (const bfu*)(p.ws + OFF_WTIN), (x * 8 + lt / 24) * 256, (lt % 24) * 128, smem, 1, nullptr);
      } else {
        for (int t = bid; t < 64 * 24; t += G)
          gemm_tile<2>(p, (const bfu*)(p.ws + OFF_HBUF), (const bfu*)(p.ws + OFF_WTIN), (t / 24) * 256, (t % 24) * 128, smem, 1, nullptr);
      }
      break;
    case 9: if (PH_ON(9))
      for (int it = bid; it < 1024; it += G) sgu_item(p, it, smem);
      break;
    case 10: if (PH_ON(10))
      if ((G & 7) == 0) {
        const int x = bid & 7;
        for (int lt = bid >> 3; lt < 64; lt += G >> 3)
          gemm_tile<1>(p, (const bfu*)(p.ws + OFF_HBUF), (const bfu*)(p.ws + OFF_WTOUT1), (x * 8 + lt / 8) * 256, (lt % 8) * 128, smem, 1, p.out);
      } else {
        for (int t = bid; t < 64 * 8; t += G)
          gemm_tile<1>(p, (const bfu*)(p.ws + OFF_HBUF), (const bfu*)(p.ws + OFF_WTOUT1), (t / 8) * 256, (t % 8) * 128, smem, 1, p.out);
      }
      break;
    default: break;
  }
}


#define XB_TMO      128
#define XB_XCNT(j)  (256  + 64 * (j))
#define XB_XSUB(j)  (1280 + 64 * (j))
#define XB_XGEN(j)  (2304 + 64 * (j))
#define XB_TOP      3328
#define XB_TOPGEN   3392
#define XCD_BAR_WORDS 3456
#define XB_SPIN_CAP (1u << 18)
#define LAS __attribute__((address_space(3)))

__device__ __forceinline__ unsigned xb_ld(unsigned* p)              { return __hip_atomic_load(p, __ATOMIC_RELAXED, __HIP_MEMORY_SCOPE_AGENT); }
__device__ __forceinline__ unsigned xb_add(unsigned* p, unsigned v) { return __hip_atomic_fetch_add(p, v, __ATOMIC_RELAXED, __HIP_MEMORY_SCOPE_AGENT); }
__device__ __forceinline__ unsigned xb_xcc_id() { return (unsigned)__builtin_amdgcn_s_getreg((3 << 11) | 20) & 0xFu; }
#define XB_SPIN(cond, bar) do { unsigned _sp = 0; while (cond) { __builtin_amdgcn_s_sleep(1); \
    if ((++_sp & 255u) == 0u) { if (xb_ld(&(bar)[XB_TMO])) break; if (_sp > XB_SPIN_CAP) { atomicAdd(&(bar)[XB_TMO], 1u); break; } } } } while (0)

struct XcdBarrier {
    unsigned* bar; unsigned x;
    volatile LAS unsigned* st;
};

__device__ __forceinline__ XcdBarrier xcd_barrier_post(unsigned* bar, volatile LAS unsigned* st) {
    XcdBarrier b; b.bar = bar; b.x = xb_xcc_id(); b.st = st;
    if (threadIdx.x == 0) (void)xb_add(&bar[XB_XCNT(b.x)], 1u);
    return b;
}
__device__ __forceinline__ void xcd_barrier_complete(unsigned* bar, unsigned x, unsigned& nloc, unsigned& nx) {
    const unsigned G = gridDim.x * gridDim.y * gridDim.z;
    unsigned sum, cnt, mine, sp = 0u;
    for (;;) {
        sum = 0u; cnt = 0u; mine = 0u;
#pragma unroll
        for (unsigned j = 0; j < 16; ++j) { const unsigned c = xb_ld(&bar[XB_XCNT(j)]); sum += c; cnt += (c > 0u) ? 1u : 0u; mine = (j == x) ? c : mine; }
        if (sum == G) break;
        __builtin_amdgcn_s_sleep(1);
        if ((++sp & 255u) == 0u) { if (xb_ld(&bar[XB_TMO])) break; if (sp > XB_SPIN_CAP) { atomicAdd(&bar[XB_TMO], 1u); break; } }
    }
    nloc = mine > 0u ? mine : 1u; nx = cnt > 0u ? cnt : 1u;
}

__device__ __forceinline__ void xcd_barrier(const XcdBarrier& b) {
    asm volatile("s_waitcnt vmcnt(0)" ::: "memory");
    __syncthreads();
    if (threadIdx.x == 0) {
        unsigned* bar = b.bar;
        __builtin_amdgcn_s_waitcnt(0);
        unsigned nloc = b.st[0], nx = b.st[1];
        if (nloc == 0u) { xcd_barrier_complete(bar, b.x, nloc, nx); b.st[0] = nloc; b.st[1] = nx; }
        const unsigned old = xb_add(&bar[XB_XSUB(b.x)], 1u);
        const unsigned gen = old / nloc;
        if (old + 1u == (gen + 1u) * nloc) {
            __builtin_amdgcn_fence(__ATOMIC_RELEASE, "agent");
            asm volatile("s_waitcnt vmcnt(0)" ::: "memory");
            const unsigned og = xb_add(&bar[XB_TOP], 1u);
            const unsigned tg = og / nx;
            if (og + 1u == (tg + 1u) * nx) xb_add(&bar[XB_TOPGEN], 1u);
            else XB_SPIN(xb_ld(&bar[XB_TOPGEN]) == tg, bar);
            __builtin_amdgcn_fence(__ATOMIC_ACQUIRE, "agent");
            xb_add(&bar[XB_XGEN(b.x)], 1u);
            asm volatile("s_waitcnt vmcnt(0)" ::: "memory");
        } else {
            XB_SPIN(xb_ld(&bar[XB_XGEN(b.x)]) == gen, bar);
            __builtin_amdgcn_fence(__ATOMIC_ACQUIRE, "agent");
            asm volatile("s_waitcnt vmcnt(0)" ::: "memory");
        }
    }
    __syncthreads();
}


constexpr int NPHASE = 11;

__global__ void __launch_bounds__(256, 2) fwd_mega(Params p, int never) {
  __shared__ __attribute__((aligned(16))) char smem[65536];
  cg::grid_group grid = cg::this_grid();
  if (never < 0) grid.sync();
  __shared__ uint4 xb_words;
  if (threadIdx.x == 0) xb_words = make_uint4(0u, 0u, 0u, 0u);
  __syncthreads();
  XcdBarrier xb = xcd_barrier_post((unsigned*)(p.ws + OFF_BAR), (volatile LAS unsigned*)&xb_words);
#ifndef REP_PH
#define REP_PH -1
#endif
#define PHASE(n)                                                      \
  run_phase<n>(p, smem, false);                                       \
  if (REP_PH == n) { xcd_barrier(xb); run_phase<n>(p, smem, true); }  \
  if (n + 1 < NPHASE) xcd_barrier(xb);
  PHASE(0) PHASE(1) PHASE(2) PHASE(3) PHASE(4) PHASE(5) PHASE(6) PHASE(7) PHASE(8) PHASE(9) PHASE(10)
}

extern "C" void kernel_launch(void* const* d_in, const int* in_sizes, int n_in, void* d_out, int out_size, void* d_ws,
                              size_t ws_size, hipStream_t stream) {
  Params p{};
  p.x = (const float*)d_in[0]; p.c = (const float*)d_in[1]; p.ln_g = (const float*)d_in[2];
  p.ada_w = (const float*)d_in[3]; p.ada_b = (const float*)d_in[4]; p.w_in = (const float*)d_in[5];
  p.w_out = (const float*)d_in[6]; p.a_q_g = (const float*)d_in[7]; p.a_k_g = (const float*)d_in[8];
  p.conv_w = (const float*)d_in[9]; p.conv_b = (const float*)d_in[10]; p.wq = (const float*)d_in[11];
  p.wk = (const float*)d_in[12]; p.wv = (const float*)d_in[13]; p.w_gates = (const float*)d_in[14];
  p.b_gates = (const float*)d_in[15]; p.out_g = (const float*)d_in[16]; p.skip = (const float*)d_in[17];
  p.c_ln_g = (const float*)d_in[18]; p.c_ln_b = (const float*)d_in[19]; p.c_ws = (const float*)d_in[20];
  p.c_bs = (const float*)d_in[21];
  p.out = (float*)d_out;
  p.ws = (char*)d_ws;
  static int grid_blocks = 0;
  if (!grid_blocks) {
    int dev = 0, cus = 0, per_cu = 0;
    hipGetDevice(&dev);
    hipDeviceGetAttribute(&cus, hipDeviceAttributeMultiprocessorCount, dev);
    hipOccupancyMaxActiveBlocksPerMultiprocessor(&per_cu, fwd_mega, 256, 0);
    if (per_cu > 2) per_cu = 2;
    if (per_cu < 1) per_cu = 1;
    grid_blocks = cus * per_cu;
  }
  hipMemsetAsync((char*)d_ws + OFF_BAR, 0, XCD_BAR_WORDS * 4, stream);
  int never = 0;
  void* args[] = {&p, &never};
  hipError_t e = hipLaunchCooperativeKernel((void*)fwd_mega, dim3(grid_blocks), dim3(256), args, 0, stream);
  if (e != hipSuccess) fprintf(stderr, "cooperative launch failed: %s (grid %d)\n", hipGetErrorString(e), grid_blocks);
}
```

```cpp
#include <hip/hip_runtime.h>
#include <hip/hip_cooperative_groups.h>
#include <stdint.h>
#include <cstdio>
#include <type_traits>
namespace cg = cooperative_groups;
#define DI __device__ __forceinline__

#ifndef MK_FUSED
#define MK_FUSED 1
#endif

typedef unsigned short bfu;
typedef short bf16x8 __attribute__((ext_vector_type(8)));
typedef float f32x16 __attribute__((ext_vector_type(16)));
typedef float f32x2 __attribute__((ext_vector_type(2)));
typedef __bf16 bf16x2v __attribute__((ext_vector_type(2)));
typedef unsigned u32x4 __attribute__((ext_vector_type(4)));
typedef unsigned u32x2 __attribute__((ext_vector_type(2)));

#define MFMA(a, b, c) __builtin_amdgcn_mfma_f32_32x32x16_bf16((a), (b), (c), 0, 0, 0)

DI unsigned pack2(float a, float b) { f32x2 v = {a, b}; bf16x2v r = __builtin_convertvector(v, bf16x2v); return __builtin_bit_cast(unsigned, r); }
DI float bflo(unsigned u) { return __uint_as_float(u << 16); }
DI float bfhi(unsigned u) { return __uint_as_float(u & 0xffff0000u); }
DI bfu f2bf(float a) { return (bfu)(pack2(a, 0.f) & 0xffffu); }
DI float bf2f(bfu h) { return __uint_as_float(((unsigned)h) << 16); }
DI int tid_l() { int t = threadIdx.x; asm volatile("" : "+v"(t)); return t; }
DI int crow(int i, int hh) { return (i & 3) + 8 * (i >> 2) + 4 * hh; }
DI float silu_f(float x) { return x * __builtin_amdgcn_rcpf(1.f + __builtin_amdgcn_exp2f(-1.4426950408889634f * x)); }
DI float gelu_f(float x) {
  const float u2 = 2.3022081981443144f * (x + 0.044715f * x * x * x);
  return x * __builtin_amdgcn_rcpf(1.f + __builtin_amdgcn_exp2f(-u2));
}
DI bf16x8 as_frag(u32x4 v) { return __builtin_bit_cast(bf16x8, v); }
DI void load_pair16(const bfu* p0, int hh, u32x2& a, u32x2& b) {
  const u32x4 l = *(const u32x4*)(p0 + 8 * hh);
  const auto s0 = __builtin_amdgcn_permlane32_swap(l[0], l[2], false, false);
  const auto s1 = __builtin_amdgcn_permlane32_swap(l[1], l[3], false, false);
  a[0] = s0[0]; a[1] = s1[0]; b[0] = s0[1]; b[1] = s1[1];
}
DI void store_pair16(bfu* p0, u32x2 a, u32x2 b, int hh) {
  const auto s0 = __builtin_amdgcn_permlane32_swap(a[0], b[0], false, false);
  const auto s1 = __builtin_amdgcn_permlane32_swap(a[1], b[1], false, false);
  u32x4 o = {s0[0], s1[0], s0[1], s1[1]};
  *(u32x4*)(p0 + 8 * hh) = o;
}

constexpr int NB = 4, SEQ = 4096, DM = 1024, NTOK = NB * SEQ;

constexpr size_t OFF_WTIN   = 0;
constexpr size_t OFF_WTOUT0 = OFF_WTIN + 6291456;
constexpr size_t OFF_WTOUT1 = OFF_WTOUT0 + 2097152;
constexpr size_t OFF_WSB    = OFF_WTOUT1 + 2097152;
constexpr size_t OFF_GT     = OFF_WSB + 262144;
constexpr size_t OFF_MODP   = OFF_GT + 65536;
constexpr size_t OFF_KSUM   = OFF_MODP + 1572864;
constexpr size_t OFF_CUM    = OFF_KSUM + 524288;
constexpr size_t OFF_AG     = OFF_CUM + 262144;
constexpr size_t OFF_TOT    = OFF_AG + 262144;
constexpr size_t OFF_HBUF   = OFF_TOT + 4096;
constexpr size_t OFF_PROJ   = OFF_HBUF + 33554432;
constexpr size_t OFF_MIX    = OFF_PROJ + 100663296;
constexpr size_t OFF_VT     = OFF_MIX;
constexpr size_t OFF_QM     = OFF_MIX + 16777216;
constexpr size_t OFF_KM     = OFF_QM + 16777216;
constexpr size_t OFF_VM     = OFF_KM + 16777216;
constexpr size_t OFF_XC     = OFF_VM + 16777216;
constexpr size_t OFF_UST    = OFF_XC + 16777216;
constexpr size_t OFF_END    = OFF_UST + 33816576;
constexpr size_t OFF_KT     = OFF_HBUF;
constexpr size_t OFF_GVT    = OFF_MIX;
constexpr size_t OFF_STATS  = OFF_MIX + 33554432;
constexpr size_t OFF_X1B    = OFF_MIX + 37748736;
constexpr size_t OFF_MODF   = OFF_END;
constexpr size_t OFF_BAR    = OFF_MODF + 98304;
static_assert(OFF_BAR + 16384 <= 268435456ull, "workspace overflow");

struct Params {
  const float *x, *c, *ln_g, *ada_w, *ada_b, *w_in, *w_out, *a_q_g, *a_k_g, *conv_w, *conv_b, *wq, *wk, *wv,
      *w_gates, *b_gates, *out_g, *skip, *c_ln_g, *c_ln_b, *c_ws, *c_bs;
  float* out;
  char* ws;
};

DI void transpose_tile(const float* __restrict__ src, bfu* __restrict__ dst, int K, int N, int k0, int n0, float* st) {
  const int tid = tid_l();
#pragma unroll
  for (int i = 0; i < 4; ++i) {
    const int r = (tid >> 4) + 16 * i, c4 = tid & 15;
    typedef float f32x4n __attribute__((ext_vector_type(4)));
    const f32x4n v = __builtin_nontemporal_load((const f32x4n*)(src + (size_t)(k0 + r) * N + n0 + 4 * c4));
    float* d = st + r * 65 + 4 * c4;
    d[0] = v.x; d[1] = v.y; d[2] = v.z; d[3] = v.w;
  }
  __syncthreads();
#pragma unroll
  for (int i = 0; i < 2; ++i) {
    const int n = (tid >> 3) + 32 * i, kc = tid & 7;
    float f[8];
#pragma unroll
    for (int j = 0; j < 8; ++j) f[j] = st[(8 * kc + j) * 65 + n];
    u32x4 o = {pack2(f[0], f[1]), pack2(f[2], f[3]), pack2(f[4], f[5]), pack2(f[6], f[7])};
    *(u32x4*)(dst + (size_t)(n0 + n) * K + k0 + 8 * kc) = o;
  }
  __syncthreads();
}

DI void mod_item(const Params& p, int it, float* sm) {
  const int layer = it / 192, rem = it % 192, cgp = rem >> 4, ks = rem & 15;
  const int tid = tid_l();
  {
    const int b = tid >> 6, kk = tid & 63;
    const float cv = p.c[b * 1024 + ks * 64 + kk];
    sm[tid] = silu_f(cv);
  }
  __syncthreads();
  const int col = cgp * 256 + tid;
  const float* w = p.ada_w + (size_t)layer * 1024 * 3072 + (size_t)(ks * 64) * 3072 + col;
  float a0 = 0.f, a1 = 0.f, a2 = 0.f, a3 = 0.f;
#pragma unroll 16
  for (int kk = 0; kk < 64; ++kk) {
    const float wv = __builtin_nontemporal_load(w + (size_t)kk * 3072);
    a0 += sm[kk] * wv; a1 += sm[64 + kk] * wv; a2 += sm[128 + kk] * wv; a3 += sm[192 + kk] * wv;
  }
  float* o = (float*)(p.ws + OFF_MODP) + (size_t)((layer * 16 + ks) * 4) * 3072 + col;
  o[0] = a0; o[3072] = a1; o[2 * 3072] = a2; o[3 * 3072] = a3;
  __syncthreads();
}

DI void gt_item(const Params& p, int it) {
  const int ch = it * 256 + tid_l();
  bfu* gt = (bfu*)(p.ws + OFF_GT);
  for (int n = 0; n < 8; ++n) {
    float val = 0.f;
    if (ch < 512) {
      const int g = ch >> 2, ii = ch & 3;
      for (int o = 0; o < 4; ++o) {
        val += p.wq[g * 16 + ii * 4 + o] * p.w_gates[(4 * g + o) * 8 + n];
        val += p.wk[g * 16 + ii * 4 + o] * p.w_gates[(512 + 4 * g + o) * 8 + n];
      }
    } else {
      const int c2 = ch - 512, g = c2 >> 2, ii = c2 & 3;
      for (int o = 0; o < 4; ++o) val += p.wv[g * 16 + ii * 4 + o] * p.w_gates[(1024 + 4 * g + o) * 8 + n];
    }
    gt[n * 1024 + ch] = f2bf(val);
  }
  for (int n = 8; n < 32; ++n) gt[n * 1024 + ch] = 0;
}

DI void wsb_item(const Params& p, int it) {
  const int e = (it * 256 + tid_l()) * 8;
  const int t = (e >> 7) & 127, s0 = e & 127;
  float f[8];
#pragma unroll
  for (int j = 0; j < 8; ++j) f[j] = (s0 + j <= t) ? p.c_ws[e + j] : 0.f;
  u32x4 o = {pack2(f[0], f[1]), pack2(f[2], f[3]), pack2(f[4], f[5]), pack2(f[6], f[7])};
  *(u32x4*)((bfu*)(p.ws + OFF_WSB) + e) = o;
}

DI void norm_item(const Params& p, const float* __restrict__ xin, int layer, int it, float* sm) {
  float* sSc = sm;
  float* sSh = sm + 1024;
  const int tid = tid_l();
  const int row0 = it * 32;
  const int b = row0 >> 12;
  if (layer == 0) {
    const float* modp = (const float*)(p.ws + OFF_MODP);
#pragma unroll
    for (int cc = 0; cc < 4; ++cc) {
      const int col = tid + 256 * cc;
      float sc = p.ada_b[1024 + col], sh = p.ada_b[col];
#pragma unroll
      for (int ks = 0; ks < 16; ++ks) {
        const float* mp = modp + (size_t)(ks * 4 + b) * 3072;
        sc += mp[1024 + col];
        sh += mp[col];
      }
      sSc[col] = p.ln_g[col] * (1.f + sc);
      sSh[col] = sh;
    }
  } else {
    const float* mf = (const float*)(p.ws + OFF_MODF) + (size_t)(4 + b) * 3072;
#pragma unroll
    for (int cc = 0; cc < 4; ++cc) {
      const int col = tid + 256 * cc;
      sSc[col] = p.ln_g[1024 + col] * (1.f + mf[1024 + col]);
      sSh[col] = mf[col];
    }
  }
  __syncthreads();
  const int w = tid >> 6, lane = tid & 63;
  bfu* hb = (bfu*)(p.ws + OFF_HBUF);
#pragma unroll 1
  for (int rb = 0; rb < 2; ++rb) {
    const int rowb = row0 + w * 8 + rb * 4;
    float4 v[4][4];
    if (layer == 0) {
#pragma unroll
      for (int q = 0; q < 4; ++q)
#pragma unroll
        for (int j = 0; j < 4; ++j) {
          typedef float f32x4n __attribute__((ext_vector_type(4)));
          const f32x4n xv = __builtin_nontemporal_load((const f32x4n*)(xin + (size_t)(rowb + q) * 1024 + lane * 4 + 256 * j));
          v[q][j].x = xv[0]; v[q][j].y = xv[1]; v[q][j].z = xv[2]; v[q][j].w = xv[3];
        }
    } else {
      const bfu* x1b = (const bfu*)(p.ws + OFF_X1B);
#pragma unroll
      for (int q = 0; q < 4; ++q)
#pragma unroll
        for (int j = 0; j < 4; ++j) {
          const u32x2 u = *(const u32x2*)(x1b + (size_t)(rowb + q) * 1024 + lane * 4 + 256 * j);
          v[q][j].x = bflo(u[0]); v[q][j].y = bfhi(u[0]); v[q][j].z = bflo(u[1]); v[q][j].w = bfhi(u[1]);
        }
    }
    float ss[4];
#pragma unroll
    for (int q = 0; q < 4; ++q) {
      float a = 0.f;
#pragma unroll
      for (int j = 0; j < 4; ++j) a += v[q][j].x * v[q][j].x + v[q][j].y * v[q][j].y + v[q][j].z * v[q][j].z + v[q][j].w * v[q][j].w;
      ss[q] = a;
    }
#pragma unroll
    for (int off = 32; off >= 1; off >>= 1)
#pragma unroll
      for (int q = 0; q < 4; ++q) ss[q] += __shfl_xor(ss[q], off);
#pragma unroll
    for (int q = 0; q < 4; ++q) {
      const float rstd = rsqrtf(ss[q] * (1.f / 1024.f) + 1e-6f);
#pragma unroll
      for (int j = 0; j < 4; ++j) {
        const int col = lane * 4 + 256 * j;
        const float4 sc4 = *(const float4*)(sSc + col);
        const float4 sh4 = *(const float4*)(sSh + col);
        const float y0 = v[q][j].x * rstd * sc4.x + sh4.x;
        const float y1 = v[q][j].y * rstd * sc4.y + sh4.y;
        const float y2 = v[q][j].z * rstd * sc4.z + sh4.z;
        const float y3 = v[q][j].w * rstd * sc4.w + sh4.w;
        u32x2 o = {pack2(y0, y1), pack2(y2, y3)};
        *(u32x2*)(hb + (size_t)(rowb + q) * 1024 + col) = o;
      }
    }
  }
  __syncthreads();
}

DI void modfin_item(const Params& p, int it) {
  const int idx = it * 256 + tid_l();
  const int layer = idx / 12288, rem = idx % 12288, b = rem / 3072, col = rem % 3072;
  const float* modp = (const float*)(p.ws + OFF_MODP);
  float a = p.ada_b[layer * 3072 + col];
#pragma unroll
  for (int ks = 0; ks < 16; ++ks) a += modp[(size_t)((layer * 16 + ks) * 4 + b) * 3072 + col];
  ((float*)(p.ws + OFF_MODF))[idx] = a;
}

#define GEMM_GL(KT)                                                                        \
  {                                                                                        \
    _Pragma("unroll") for (int i = 0; i < 8; ++i) ra[i] = *(const u32x4*)(ag + (size_t)i * 32 * K + (KT) * 64); \
    _Pragma("unroll") for (int i = 0; i < 4; ++i) rw[i] = *(const u32x4*)(wg + (size_t)i * 32 * K + (KT) * 64); \
  }
#define GEMM_LS()                                                                          \
  {                                                                                        \
    _Pragma("unroll") for (int i = 0; i < 8; ++i) *(u32x4*)(sA + ((EPI != 1) ? ldsa[i] : lds_w + i * 4096)) = ra[i]; \
    _Pragma("unroll") for (int i = 0; i < 4; ++i) *(u32x4*)(sW + lds_w + i * 4096) = rw[i]; \
  }
#define GEMM_COMPUTE()                                                                     \
  {                                                                                        \
    _Pragma("unroll") for (int kk = 0; kk < 4; ++kk) {                                     \
      bf16x8 fa[4], fw[2];                                                                 \
      const int sw = (((2 * kk + hh) ^ ((r >> 1) & 7)) << 4);                              \
      _Pragma("unroll") for (int mt = 0; mt < 4; ++mt)                                     \
        fa[mt] = *(const bf16x8*)(sA + (wm * 128 + mt * 32 + r) * 128 + sw);               \
      _Pragma("unroll") for (int nt = 0; nt < 2; ++nt)                                     \
        fw[nt] = *(const bf16x8*)(sW + (wn * 64 + nt * 32 + r) * 128 + sw);                \
      _Pragma("unroll") for (int nt = 0; nt < 2; ++nt)                                     \
        _Pragma("unroll") for (int mt = 0; mt < 4; ++mt)                                   \
          acc[nt][mt] = (EPI == 1) ? MFMA(fa[mt], fw[nt], acc[nt][mt]) : MFMA(fw[nt], fa[mt], acc[nt][mt]); \
    }                                                                                      \
  }

template <int EPI>
DI void gemm_tile(const Params& p, const bfu* __restrict__ A, const bfu* __restrict__ W, int m0, int n0, char* smem,
                  int layer, const float* __restrict__ resid) {
  constexpr int K = 1024;
  const int tid = tid_l(), lane = tid & 63, w = tid >> 6, r = lane & 31, hh = lane >> 5;
  const int wm = w & 1, wn = w >> 1;
  const int lrow = tid >> 3, lc = tid & 7;
  const bfu* ag = A + (size_t)(m0 + lrow) * K + lc * 8;
  const bfu* wg = W + (size_t)(n0 + lrow) * K + lc * 8;
  const int lds_w = lrow * 128 + ((lc ^ ((lrow >> 1) & 7)) << 4);
  int ldsa[8];
#pragma unroll
  for (int i = 0; i < 8; ++i) {
    const int prow = (i >> 2) * 128 + (2 * ((i & 3) >> 1) + (lrow & 1)) * 32 + (lrow >> 1) + 16 * (i & 1);
    ldsa[i] = prow * 128 + ((lc ^ ((prow >> 1) & 7)) << 4);
  }
#define GTOK(mt) (mw + 64 * ((mt) >> 1) + ((mt) & 1) + 2 * r)
  char* sA = smem;
  char* sW = smem + 32768;
  u32x4 ra[8], rw[4];
  GEMM_GL(0);
  float gate[2];
  if (EPI == 1) {
    const float* mf = (const float*)(p.ws + OFF_MODF) + (size_t)(layer * 4 + (m0 >> 12)) * 3072 + 2048 + n0 + wn * 64 + r;
    gate[0] = mf[0];
    gate[1] = mf[32];
  }
  f32x16 acc[2][4];
#pragma unroll
  for (int a = 0; a < 2; ++a)
#pragma unroll
    for (int b2 = 0; b2 < 4; ++b2)
#pragma unroll
      for (int i = 0; i < 16; ++i) acc[a][b2][i] = 0.f;
  GEMM_LS();
  __syncthreads();
#pragma unroll 1
  for (int kt = 0; kt < 16; ++kt) {
    const int kn = (kt + 1 < 16) ? kt + 1 : 15;
    GEMM_GL(kn);
    __builtin_amdgcn_sched_barrier(0);
    GEMM_COMPUTE();
    __syncthreads();
    GEMM_LS();
    __syncthreads();
  }

  const int nb = n0 + wn * 64;
  const int b = m0 >> 12;
  const int mw = m0 + wm * 128;
  bfu* proj = (bfu*)(p.ws + OFF_PROJ);
  if (EPI == 1) {
#pragma unroll
    for (int mt = 0; mt < 4; ++mt)
#pragma unroll
      for (int i = 0; i < 16; ++i) {
        const int token = mw + mt * 32 + crow(i, hh);
        const size_t off = (size_t)token * 1024 + nb + r;
        if (layer == 0) {
          const float r0 = __builtin_nontemporal_load(resid + off), r1 = __builtin_nontemporal_load(resid + off + 32);
          bfu* x1b = (bfu*)(p.ws + OFF_X1B);
          x1b[off] = f2bf(r0 + gate[0] * acc[0][mt][i]);
          x1b[off + 32] = f2bf(r1 + gate[1] * acc[1][mt][i]);
        } else {
          const bfu* x1b = (const bfu*)(p.ws + OFF_X1B);
          const float r0 = bf2f(x1b[off]), r1 = bf2f(x1b[off + 32]);
          __builtin_nontemporal_store(r0 + gate[0] * acc[0][mt][i], p.out + off);
          __builtin_nontemporal_store(r1 + gate[1] * acc[1][mt][i], p.out + off + 32);
        }
      }
  } else if (EPI == 0) {
    if (nb < 1024) {
      const bool isk = nb >= 512;
      const float* gg = isk ? p.a_k_g : p.a_q_g;
      float gv[2][16], cs[2][16];
#pragma unroll
      for (int nt = 0; nt < 2; ++nt)
#pragma unroll
        for (int i = 0; i < 16; ++i) { gv[nt][i] = gg[nt * 32 + crow(i, hh)]; cs[nt][i] = 0.f; }
#pragma unroll
      for (int mt = 0; mt < 4; ++mt) {
        float ss = 0.f;
#pragma unroll
        for (int nt = 0; nt < 2; ++nt)
#pragma unroll
          for (int i = 0; i < 16; ++i) ss += acc[nt][mt][i] * acc[nt][mt][i];
        ss += __shfl_xor(ss, 32);
        const float rstd = rsqrtf(ss * (1.f / 64.f) + 1e-6f);
        const int token = GTOK(mt);
        bfu* dst = proj + (size_t)token * 3072 + nb;
#pragma unroll
        for (int nt = 0; nt < 2; ++nt) {
          u32x2 ob[4];
#pragma unroll
          for (int g4 = 0; g4 < 4; ++g4) {
            float v[4];
#pragma unroll
            for (int q = 0; q < 4; ++q) {
              v[q] = acc[nt][mt][4 * g4 + q] * rstd * gv[nt][4 * g4 + q];
              cs[nt][4 * g4 + q] += v[q];
            }
            ob[g4][0] = pack2(v[0], v[1]); ob[g4][1] = pack2(v[2], v[3]);
          }
          store_pair16(dst + nt * 32, ob[0], ob[1], hh);
          store_pair16(dst + nt * 32 + 16, ob[2], ob[3], hh);
        }
      }
      if (isk) {
        const int head = (nb - 512) >> 6;
        const int tokblk = (mw & 4095) >> 7;
        float* ks = (float*)(p.ws + OFF_KSUM) + (size_t)((b * 8 + head) * 32 + tokblk) * 64;
#pragma unroll
        for (int nt = 0; nt < 2; ++nt)
#pragma unroll
          for (int i = 0; i < 16; ++i) {
            float v = cs[nt][i];
#pragma unroll
            for (int off = 1; off < 32; off <<= 1) v += __shfl_xor(v, off);
            if (r == 0) ks[nt * 32 + crow(i, hh)] = v;
          }
      }
    } else if (nb < 1536) {
      const int head = (nb - 1024) >> 6;
      bfu* vt = (bfu*)(p.ws + OFF_VT) + (size_t)((b * 8 + head) * 64) * 4096;
#pragma unroll
      for (int nt = 0; nt < 2; ++nt)
#pragma unroll
        for (int a = 0; a < 2; ++a) {
          const int s0 = (mw & 4095) + 64 * a + 2 * r;
#pragma unroll
          for (int i = 0; i < 16; ++i)
            *(unsigned*)(vt + (size_t)(nt * 32 + crow(i, hh)) * 4096 + s0) = pack2(acc[nt][2 * a][i], acc[nt][2 * a + 1][i]);
        }
    } else {
      const bool act = (nb < 2048) || (nb >= 2560);
#pragma unroll
      for (int nt = 0; nt < 2; ++nt)
#pragma unroll
        for (int mt = 0; mt < 4; ++mt) {
          const int token = GTOK(mt);
          bfu* dst = proj + (size_t)token * 3072 + nb + nt * 32;
          u32x2 ob[4];
#pragma unroll
          for (int g4 = 0; g4 < 4; ++g4) {
            float v[4];
#pragma unroll
            for (int q = 0; q < 4; ++q) { v[q] = acc[nt][mt][4 * g4 + q]; if (act) v[q] = silu_f(v[q]); }
            ob[g4][0] = pack2(v[0], v[1]); ob[g4][1] = pack2(v[2], v[3]);
          }
          store_pair16(dst, ob[0], ob[1], hh);
          store_pair16(dst + 16, ob[2], ob[3], hh);
        }
    }
  } else {
    if (nb >= 1024 && nb < 2048) {
      const int c0 = nb - 1024;
      bfu* gvt = (bfu*)(p.ws + OFF_GVT) + (size_t)(b * 1024 + c0) * 4096;
      float* stats = (float*)(p.ws + OFF_STATS);
#pragma unroll
      for (int mt = 0; mt < 4; ++mt) {
        const int token = GTOK(mt);
        float s1 = 0.f, s2 = 0.f;
#pragma unroll
        for (int nt = 0; nt < 2; ++nt)
#pragma unroll
          for (int i = 0; i < 16; ++i) {
            const float v = gelu_f(acc[nt][mt][i]);
            s1 += v; s2 += v * v;
            acc[nt][mt][i] = v;
          }
        s1 += __shfl_xor(s1, 32);
        s2 += __shfl_xor(s2, 32);
        if (hh == 0) {
          float2 o; o.x = s1; o.y = s2;
          *(float2*)(stats + ((size_t)token * 16 + (c0 >> 6)) * 2) = o;
        }
      }
#pragma unroll
      for (int nt = 0; nt < 2; ++nt)
#pragma unroll
        for (int a = 0; a < 2; ++a) {
          const int s0 = (mw & 4095) + 64 * a + 2 * r;
#pragma unroll
          for (int i = 0; i < 16; ++i)
            *(unsigned*)(gvt + (size_t)(nt * 32 + crow(i, hh)) * 4096 + s0) = pack2(acc[nt][2 * a][i], acc[nt][2 * a + 1][i]);
        }
    } else {
      const bool isu = nb < 1024;
#pragma unroll
      for (int nt = 0; nt < 2; ++nt)
#pragma unroll
        for (int mt = 0; mt < 4; ++mt) {
          const int token = GTOK(mt);
          bfu* dst = proj + (size_t)token * 3072 + nb + nt * 32;
          u32x2 ob[4];
#pragma unroll
          for (int g4 = 0; g4 < 4; ++g4) {
            float v[4];
#pragma unroll
            for (int q = 0; q < 4; ++q) { const float a = acc[nt][mt][4 * g4 + q]; v[q] = isu ? gelu_f(a) : silu_f(a); }
            ob[g4][0] = pack2(v[0], v[1]); ob[g4][1] = pack2(v[2], v[3]);
          }
          store_pair16(dst, ob[0], ob[1], hh);
          store_pair16(dst + 16, ob[2], ob[3], hh);
        }
    }
  }
}

#undef GTOK
DI void mlstm_prep_item(const Params& p, int it, char* smem) {
  const int tid = tid_l(), lane = tid & 63, w = __builtin_amdgcn_readfirstlane(tid >> 6), r = lane & 31, hh = lane >> 5;
  const int b = it >> 6, c = it & 63;
  const int tok0 = b * 4096 + c * 64;
  const bfu* proj = (const bfu*)(p.ws + OFF_PROJ);
  bfu* qm = (bfu*)(p.ws + OFF_QM);
  bfu* km = (bfu*)(p.ws + OFF_KM);
  bfu* vm = (bfu*)(p.ws + OFF_VM);
  bfu* xcb = (bfu*)(p.ws + OFF_XC);
  bfu* ktm = (bfu*)(p.ws + OFF_KT);
  float* sG = (float*)smem;
  float* sWt = (float*)(smem + 8192);
  {
    const int blk = tid & 127, th = tid >> 7;
    const int ch = blk * 4;
    float cw[4][4], cb[4], q_w[4][4], k_w[4][4], v_w[4][4];
#pragma unroll
    for (int j = 0; j < 4; ++j)
#pragma unroll
      for (int i = 0; i < 4; ++i) {
        cw[j][i] = p.conv_w[j * 512 + ch + i];
        q_w[j][i] = p.wq[blk * 16 + j * 4 + i];
        k_w[j][i] = p.wk[blk * 16 + j * 4 + i];
        v_w[j][i] = p.wv[blk * 16 + j * 4 + i];
      }
#pragma unroll
    for (int i = 0; i < 4; ++i) cb[i] = p.conv_b[ch + i];
    float win[4][4];
    const int sl0 = c * 64 + th * 32;
#pragma unroll
    for (int j = 0; j < 3; ++j) {
      const int sp = sl0 - 3 + j;
      if (sp >= 0) {
        const u32x2 v = *(const u32x2*)(proj + (size_t)(b * 4096 + sp) * 3072 + 2048 + ch);
        win[j][0] = bflo(v[0]); win[j][1] = bfhi(v[0]); win[j][2] = bflo(v[1]); win[j][3] = bfhi(v[1]);
      } else {
        win[j][0] = win[j][1] = win[j][2] = win[j][3] = 0.f;
      }
    }
    const float kscale = 0.08838834764831845f;
    const bfu* bxp = proj + ((size_t)b * 4096 + sl0) * 3072 + 2048 + ch;
    u32x2 cur[8], nxt[8];
    float kk8[4][8], vv8[4][8];
#pragma unroll
    for (int q = 0; q < 8; ++q) cur[q] = *(const u32x2*)(bxp + (size_t)q * 3072);
#pragma unroll 1
    for (int t8 = 0; t8 < 4; ++t8) {
      const int tn = (t8 < 3) ? (t8 + 1) * 8 : 24;
#pragma unroll
      for (int q = 0; q < 8; ++q) nxt[q] = *(const u32x2*)(bxp + (size_t)(tn + q) * 3072);
      __builtin_amdgcn_sched_barrier(0);
#pragma unroll
      for (int q = 0; q < 8; ++q) {
        const size_t token = (size_t)b * 4096 + sl0 + t8 * 8 + q;
        const u32x2 v = cur[q];
        win[3][0] = bflo(v[0]); win[3][1] = bfhi(v[0]); win[3][2] = bflo(v[1]); win[3][3] = bfhi(v[1]);
        float xc[4], bq[4], bk[4], bv[4];
#pragma unroll
        for (int i = 0; i < 4; ++i) {
          float a = cb[i];
#pragma unroll
          for (int j = 0; j < 4; ++j) a += cw[j][i] * win[j][i];
          xc[i] = silu_f(a);
        }
#pragma unroll
        for (int o = 0; o < 4; ++o) {
          float aq = 0.f, ak = 0.f, av = 0.f;
#pragma unroll
          for (int i = 0; i < 4; ++i) { aq += xc[i] * q_w[i][o]; ak += xc[i] * k_w[i][o]; av += win[3][i] * v_w[i][o]; }
          bq[o] = aq; bk[o] = ak * kscale; bv[o] = av;
        }
        u32x2 o;
        o[0] = pack2(bq[0], bq[1]); o[1] = pack2(bq[2], bq[3]); *(u32x2*)(qm + token * 512 + ch) = o;
        o[0] = pack2(bk[0], bk[1]); o[1] = pack2(bk[2], bk[3]); *(u32x2*)(km + token * 512 + ch) = o;
#pragma unroll
        for (int o4 = 0; o4 < 4; ++o4) { kk8[o4][q] = bk[o4]; vv8[o4][q] = bv[o4]; }
        o[0] = pack2(xc[0], xc[1]); o[1] = pack2(xc[2], xc[3]); *(u32x2*)(xcb + token * 512 + ch) = o;
#pragma unroll
        for (int j = 0; j < 3; ++j)
#pragma unroll
          for (int i = 0; i < 4; ++i) win[j][i] = win[j + 1][i];
      }
#pragma unroll
      for (int o4 = 0; o4 < 4; ++o4) {
        const size_t off = ((size_t)((b * 4 + (blk >> 5)) * 64 + c) * 128 + (blk & 31) * 4 + o4) * 64 + th * 32 + t8 * 8;
        u32x4 pk = {pack2(kk8[o4][0], kk8[o4][1]), pack2(kk8[o4][2], kk8[o4][3]), pack2(kk8[o4][4], kk8[o4][5]), pack2(kk8[o4][6], kk8[o4][7])};
        *(u32x4*)(ktm + off) = pk;
        u32x4 pv = {pack2(vv8[o4][0], vv8[o4][1]), pack2(vv8[o4][2], vv8[o4][3]), pack2(vv8[o4][4], vv8[o4][5]), pack2(vv8[o4][6], vv8[o4][7])};
        *(u32x4*)(vm + off) = pv;
      }
#pragma unroll
      for (int q = 0; q < 8; ++q) cur[q] = nxt[q];
    }
  }
  __threadfence_block();
  __syncthreads();
  {
    const bfu* gt = (const bfu*)(p.ws + OFF_GT);
    f32x16 acc[2];
#pragma unroll
    for (int tt = 0; tt < 2; ++tt)
#pragma unroll
      for (int i = 0; i < 16; ++i) acc[tt][i] = 0.f;
#pragma unroll 4
    for (int ksi = 0; ksi < 16; ++ksi) {
      const int ch = (16 * w + ksi) * 16 + 8 * hh;
      const bf16x8 af = as_frag(*(const u32x4*)(gt + r * 1024 + ch));
#pragma unroll
      for (int tt = 0; tt < 2; ++tt) {
        const size_t token = (size_t)tok0 + 32 * tt + r;
        const bfu* src = (ch < 512) ? (xcb + token * 512 + ch) : (proj + token * 3072 + 2048 + (ch - 512));
        const bf16x8 bfr = as_frag(*(const u32x4*)src);
        acc[tt] = MFMA(af, bfr, acc[tt]);
      }
    }
#pragma unroll
    for (int tt = 0; tt < 2; ++tt)
#pragma unroll
      for (int i = 0; i < 4; ++i) sG[(w * 8 + 4 * hh + i) * 64 + 32 * tt + r] = acc[tt][i];
  }
  __syncthreads();
  {
    const int head = w, tok = lane;
    float ig = p.b_gates[head], fg = p.b_gates[4 + head];
#pragma unroll
    for (int ww = 0; ww < 4; ++ww) { ig += sG[(ww * 8 + head) * 64 + tok]; fg += sG[(ww * 8 + 4 + head) * 64 + tok]; }
    const float lf = fminf(fg, 0.f) - log1pf(__expf(-fabsf(fg)));
    float cum = lf;
#pragma unroll
    for (int off = 1; off < 64; off <<= 1) {
      const float o = __shfl_up(cum, off);
      if (lane >= off) cum += o;
    }
    const float tot = __shfl(cum, 63);
    const float a = ig - cum;
    const int bh = b * 4 + head;
    ((float*)(p.ws + OFF_CUM))[(size_t)bh * 4096 + c * 64 + tok] = cum;
    ((float*)(p.ws + OFF_AG))[(size_t)bh * 4096 + c * 64 + tok] = a;
    if (lane == 0) ((float*)(p.ws + OFF_TOT))[bh * 64 + c] = tot;
    sWt[head * 64 + tok] = __expf(tot + a);
  }
  __syncthreads();
  {
    const int h = w;
    const int bh = b * 4 + h;
    const bfu* ktc = ktm + (size_t)(bh * 64 + c) * 128 * 64;
    const bfu* vtc = vm + (size_t)(bh * 64 + c) * 128 * 64;
    bfu* ust = (bfu*)(p.ws + OFF_UST) + (size_t)(bh * 64 + c) * 129 * 128;
    float wsr[4][8];
#pragma unroll
    for (int ss = 0; ss < 4; ++ss)
#pragma unroll
      for (int j = 0; j < 8; ++j) wsr[ss][j] = sWt[h * 64 + 16 * ss + 8 * hh + j];
    u32x4 vall[4][4];
#pragma unroll
    for (int vt = 0; vt < 4; ++vt)
#pragma unroll
      for (int ss = 0; ss < 4; ++ss) vall[vt][ss] = *(const u32x4*)(vtc + (size_t)(vt * 32 + r) * 64 + 16 * ss + 8 * hh);
    bf16x8 kall[4][4];
#pragma unroll
    for (int kt = 0; kt < 4; ++kt)
#pragma unroll
      for (int ss = 0; ss < 4; ++ss) kall[kt][ss] = as_frag(*(const u32x4*)(ktc + (size_t)(kt * 32 + r) * 64 + 16 * ss + 8 * hh));
#pragma unroll
    for (int vt = 0; vt < 5; ++vt) {
      bf16x8 vf[4];
#pragma unroll
      for (int ss = 0; ss < 4; ++ss) {
        float f[8];
        if (vt < 4) {
#pragma unroll
          for (int q = 0; q < 4; ++q) { f[2 * q] = bflo(vall[vt < 4 ? vt : 0][ss][q]) * wsr[ss][2 * q]; f[2 * q + 1] = bfhi(vall[vt < 4 ? vt : 0][ss][q]) * wsr[ss][2 * q + 1]; }
        } else {
#pragma unroll
          for (int j = 0; j < 8; ++j) f[j] = (r == 0) ? wsr[ss][j] : 0.f;
        }
        u32x4 pk = {pack2(f[0], f[1]), pack2(f[2], f[3]), pack2(f[4], f[5]), pack2(f[6], f[7])};
        vf[ss] = as_frag(pk);
      }
#pragma unroll
      for (int kp = 0; kp < 2; ++kp) {
        f32x16 acc[2];
#pragma unroll
        for (int kt = 0; kt < 2; ++kt)
#pragma unroll
          for (int i = 0; i < 16; ++i) acc[kt][i] = 0.f;
#pragma unroll
        for (int ss = 0; ss < 4; ++ss)
#pragma unroll
          for (int kt = 0; kt < 2; ++kt) acc[kt] = MFMA(kall[kp * 2 + kt][ss], vf[ss], acc[kt]);
#pragma unroll
        for (int kt = 0; kt < 2; ++kt)
#pragma unroll
          for (int gp = 0; gp < 2; ++gp) {
            u32x2 oa = {pack2(acc[kt][8 * gp], acc[kt][8 * gp + 1]), pack2(acc[kt][8 * gp + 2], acc[kt][8 * gp + 3])};
            u32x2 obb = {pack2(acc[kt][8 * gp + 4], acc[kt][8 * gp + 5]), pack2(acc[kt][8 * gp + 6], acc[kt][8 * gp + 7])};
            const auto s0 = __builtin_amdgcn_permlane32_swap(oa[0], obb[0], false, false);
            const auto s1 = __builtin_amdgcn_permlane32_swap(oa[1], obb[1], false, false);
            u32x4 o = {s0[0], s1[0], s0[1], s1[1]};
            if (vt < 4 || r == 0) *(u32x4*)(ust + (size_t)(vt * 32 + r) * 128 + (kp * 2 + kt) * 32 + 16 * gp + 8 * hh) = o;
          }
      }
    }
  }
  __syncthreads();
}

DI void scan_item(const Params& p, int it) {
  const int id = it * 256 + tid_l();
  const int bh = id / 2064, e8 = id % 2064;
  bfu* base = (bfu*)(p.ws + OFF_UST) + (size_t)bh * 64 * 16512 + e8 * 8;
  const float* tot = (const float*)(p.ws + OFF_TOT) + bh * 64;
  float st[8];
#pragma unroll
  for (int j = 0; j < 8; ++j) st[j] = 0.f;
  for (int c0 = 0; c0 < 64; c0 += 8) {
    u32x4 u[8];
#pragma unroll
    for (int j = 0; j < 8; ++j) u[j] = *(const u32x4*)(base + (size_t)(c0 + j) * 16512);
#pragma unroll
    for (int j = 0; j < 8; ++j) {
      u32x4 o = {pack2(st[0], st[1]), pack2(st[2], st[3]), pack2(st[4], st[5]), pack2(st[6], st[7])};
      *(u32x4*)(base + (size_t)(c0 + j) * 16512) = o;
      const float dec = __expf(tot[c0 + j]);
#pragma unroll
      for (int q = 0; q < 4; ++q) {
        st[2 * q] = dec * st[2 * q] + bflo(u[j][q]);
        st[2 * q + 1] = dec * st[2 * q + 1] + bfhi(u[j][q]);
      }
    }
  }
}

DI void moba_item(const Params& p, int mi, char* smem) {
  const int tid = tid_l(), lane = tid & 63, w = tid >> 6, r = lane & 31, hh = lane >> 5;
  const int jb = 15 - (mi >> 6);
  const int rem = mi & 63;
  const int half = 1 - (rem >> 5);
  const int bh = rem & 31;
  const int b = bh >> 3, h = bh & 7;
  const int q0 = jb * 256 + half * 128;
  const size_t tokbase = (size_t)b * 4096;
  const bfu* proj = (const bfu*)(p.ws + OFF_PROJ);
  const bfu* vtg = (const bfu*)(p.ws + OFF_VT) + (size_t)bh * 64 * 4096;
  float* sKM = (float*)smem;
  char* sK = smem + 4096;
  char* sV = smem + 4096 + 24576;
  {
    const float* ks = (const float*)(p.ws + OFF_KSUM) + (size_t)bh * 32 * 64;
    for (int idx = tid; idx < jb * 64; idx += 256) {
      const int n = idx >> 6, d = idx & 63;
      const float* q2 = ks + (size_t)(2 * n) * 64 + d;
      sKM[idx] = q2[0] + q2[64];
    }
  }
  const int qpos = q0 + w * 32 + r;
  const size_t qtoken = tokbase + qpos;
  u32x4 qf[4];
#pragma unroll
  for (int kk = 0; kk < 4; ++kk) qf[kk] = *(const u32x4*)(proj + qtoken * 3072 + h * 64 + kk * 16 + hh * 8);
  __syncthreads();
  unsigned sel;
  {
    float s1 = -INFINITY, s2 = -INFINITY, s3 = -INFINITY;
    int i1 = -1, i2 = -1, i3 = -1;
    for (int n = 0; n < jb; ++n) {
      float dot = 0.f;
#pragma unroll
      for (int kk = 0; kk < 4; ++kk) {
        const float* km = sKM + n * 64 + kk * 16 + hh * 8;
#pragma unroll
        for (int e = 0; e < 4; ++e) {
          dot += bflo(qf[kk][e]) * km[2 * e];
          dot += bfhi(qf[kk][e]) * km[2 * e + 1];
        }
      }
      dot += __shfl_xor(dot, 32);
      if (dot > s1) { s3 = s2; i3 = i2; s2 = s1; i2 = i1; s1 = dot; i1 = n; }
      else if (dot > s2) { s3 = s2; i3 = i2; s2 = dot; i2 = n; }
      else if (dot > s3) { s3 = dot; i3 = n; }
    }
    if (jb <= 3) sel = (1u << jb) - 1u;
    else sel = (1u << i1) | (1u << i2) | (1u << i3);
  }
  const int ntile = 4 * jb + (half ? 4 : 2);
  const int lrow = tid >> 3, lch = tid & 7;
  u32x4 kregA[2], vregA[2], kregB[2], vregB[2];
  auto gload = [&](int tix, u32x4 (&kreg)[2], u32x4 (&vreg)[2]) {
    const int n = tix >> 2, tk = tix & 3;
    const int key0 = n * 256 + tk * 64;
#pragma unroll
    for (int i = 0; i < 2; ++i) {
      const int row = lrow + 32 * i;
      kreg[i] = *(const u32x4*)(proj + (tokbase + key0 + row) * 3072 + 512 + h * 64 + lch * 8);
      vreg[i] = *(const u32x4*)(vtg + (size_t)row * 4096 + key0 + lch * 8);
    }
  };
  auto lstore = [&](int buf, u32x4 (&kreg)[2], u32x4 (&vreg)[2]) {
#pragma unroll
    for (int i = 0; i < 2; ++i) {
      const int row = lrow + 32 * i;
      const int sw = (row >> 1) & 7;
      *(u32x4*)(sK + buf * 8192 + row * 128 + ((lch ^ sw) << 4)) = kreg[i];
      const int g = lch >> 1, hf = (lch & 1) << 3;
      u32x2 lo = {vreg[i][0], vreg[i][1]}, hi = {vreg[i][2], vreg[i][3]};
      *(u32x2*)(sV + buf * 8192 + row * 128 + (((2 * g) ^ sw) << 4) + hf) = lo;
      *(u32x2*)(sV + buf * 8192 + row * 128 + (((2 * g + 1) ^ sw) << 4) + hf) = hi;
    }
  };
  const f32x16 zero16 = {0.f, 0.f, 0.f, 0.f, 0.f, 0.f, 0.f, 0.f, 0.f, 0.f, 0.f, 0.f, 0.f, 0.f, 0.f, 0.f};
  const int qmax = q0 + w * 32 + 31;
  int lofs[4];
#pragma unroll
  for (int g = 0; g < 4; ++g) lofs[g] = r * 128 + (((2 * g + hh) ^ ((r >> 1) & 7)) << 4);
  auto compute_s = [&](int tix, int buf, f32x16 (&s)[2]) {
    const int key0 = (tix >> 2) * 256 + (tix & 3) * 64;
    if (key0 <= qmax) {
      const char* kb = sK + buf * 8192;
      const bool two = (key0 + 32 <= qmax);
      if ((tix >> 2) == jb) {
        const int lim = qpos - key0 - 4 * hh;
        f32x16 b0, b1;
#pragma unroll
        for (int i = 0; i < 16; ++i) {
          const int cidx = (i & 3) + 8 * (i >> 2);
          b0[i] = (cidx <= lim) ? 0.f : -INFINITY;
          b1[i] = (two && (32 + cidx <= lim)) ? 0.f : -INFINITY;
        }
        s[0] = MFMA(*(const bf16x8*)(kb + lofs[0]), as_frag(qf[0]), b0);
#pragma unroll
        for (int kk = 1; kk < 4; ++kk) s[0] = MFMA(*(const bf16x8*)(kb + lofs[kk]), as_frag(qf[kk]), s[0]);
        if (two) {
          s[1] = MFMA(*(const bf16x8*)(kb + 4096 + lofs[0]), as_frag(qf[0]), b1);
#pragma unroll
          for (int kk = 1; kk < 4; ++kk) s[1] = MFMA(*(const bf16x8*)(kb + 4096 + lofs[kk]), as_frag(qf[kk]), s[1]);
        } else {
          s[1] = b1;
        }
      } else {
        s[0] = MFMA(*(const bf16x8*)(kb + lofs[0]), as_frag(qf[0]), zero16);
#pragma unroll
        for (int kk = 1; kk < 4; ++kk) s[0] = MFMA(*(const bf16x8*)(kb + lofs[kk]), as_frag(qf[kk]), s[0]);
        s[1] = MFMA(*(const bf16x8*)(kb + 4096 + lofs[0]), as_frag(qf[0]), zero16);
#pragma unroll
        for (int kk = 1; kk < 4; ++kk) s[1] = MFMA(*(const bf16x8*)(kb + 4096 + lofs[kk]), as_frag(qf[kk]), s[1]);
      }
    }
  };
  f32x16 oacc[2];
#pragma unroll
  for (int dt = 0; dt < 2; ++dt)
#pragma unroll
    for (int i = 0; i < 16; ++i) oacc[dt][i] = 0.f;
  float mrun = -1e30f;
  f32x16 lacc = zero16;
  const unsigned onev = (r == 0) ? 0x3F803F80u : 0u;
  const u32x4 ones4 = {onev, onev, onev, onev};
  const bf16x8 onesf = as_frag(ones4);
  const float cs = 0.125f * 1.4426950408889634f;
  auto step = [&](int tix, int b0, int b1, int b2, f32x16 (&scur)[2], f32x16 (&snext)[2], u32x4 (&kreg)[2], u32x4 (&vreg)[2]) {
    if (tix + 1 < ntile) compute_s(tix + 1, b1, snext);
    const int n = tix >> 2, tk = tix & 3;
    const int key0 = n * 256 + tk * 64;
    if (key0 <= qmax) {
      const char* vb = sV + b0 * 8192;
      const bool own = (n == jb);
      const bool lsel = own || ((sel >> n) & 1u);
      const bool act1 = (key0 + 32 <= qmax);
      float mt = scur[0][0];
#pragma unroll
      for (int i = 1; i < 16; ++i) mt = fmaxf(mt, scur[0][i]);
#pragma unroll
      for (int i = 0; i < 16; ++i) mt = fmaxf(mt, scur[1][i]);
      mt = fmaxf(mt, __shfl_xor(mt, 32));
      mt = lsel ? mt : -INFINITY;
      const float mnew = fmaxf(mrun, mt);
      const float alpha = __builtin_amdgcn_exp2f((mrun - mnew) * cs);
      mrun = mnew;
      const float nbias = (lsel && mnew > -1e29f) ? -mnew * cs : -INFINITY;
#pragma unroll
      for (int kt = 0; kt < 2; ++kt)
#pragma unroll
        for (int i = 0; i < 16; ++i) scur[kt][i] = __builtin_amdgcn_exp2f(__builtin_fmaf(scur[kt][i], cs, nbias));
      lacc[0] *= alpha;
#pragma unroll
      for (int dt = 0; dt < 2; ++dt)
#pragma unroll
        for (int i = 0; i < 16; ++i) oacc[dt][i] *= alpha;
#pragma unroll
      for (int kt = 0; kt < 2; ++kt) {
        if (kt == 0 || act1) {
#pragma unroll
          for (int ss = 0; ss < 2; ++ss) {
            u32x4 pk = {pack2(scur[kt][8 * ss], scur[kt][8 * ss + 1]), pack2(scur[kt][8 * ss + 2], scur[kt][8 * ss + 3]),
                        pack2(scur[kt][8 * ss + 4], scur[kt][8 * ss + 5]), pack2(scur[kt][8 * ss + 6], scur[kt][8 * ss + 7])};
            const bf16x8 pf = as_frag(pk);
#pragma unroll
            for (int dt = 0; dt < 2; ++dt) {
              const bf16x8 vf = *(const bf16x8*)(vb + dt * 4096 + lofs[2 * kt + ss]);
              oacc[dt] = MFMA(vf, pf, oacc[dt]);
            }
            lacc = MFMA(onesf, pf, lacc);
          }
        }
      }
    }
    lstore(b2, kreg, vreg);
    gload((tix + 4 < ntile) ? tix + 4 : ntile - 1, kreg, vreg);
    __syncthreads();
  };
  gload(0, kregA, vregA);
  gload(1, kregB, vregB);
  lstore(0, kregA, vregA);
  gload((2 < ntile) ? 2 : ntile - 1, kregA, vregA);
  lstore(1, kregB, vregB);
  gload((3 < ntile) ? 3 : ntile - 1, kregB, vregB);
  __syncthreads();
  f32x16 sa[2], sb[2];
  sa[0] = zero16; sa[1] = zero16; sb[0] = zero16; sb[1] = zero16;
  compute_s(0, 0, sa);
  {
    int b0 = 0;
#pragma unroll 1
    for (int tix = 0; tix < ntile; tix += 2) {
      const int b1 = (b0 == 2) ? 0 : b0 + 1;
      const int b2 = (b1 == 2) ? 0 : b1 + 1;
      step(tix, b0, b1, b2, sa, sb, kregA, vregA);
      if (tix + 1 < ntile) step(tix + 1, b1, b2, b0, sb, sa, kregB, vregB);
      b0 = b2;
    }
  }
  {
    const float ltot = __shfl(lacc[0], r);
    const float inv = 1.f / ltot;
    bfu* ym = (bfu*)(p.ws + OFF_HBUF);
#pragma unroll
    for (int dt = 0; dt < 2; ++dt) {
      u32x2 ob[4], azp[4];
      load_pair16(proj + qtoken * 3072 + 1536 + h * 64 + dt * 32, hh, azp[0], azp[1]);
      load_pair16(proj + qtoken * 3072 + 1536 + h * 64 + dt * 32 + 16, hh, azp[2], azp[3]);
#pragma unroll
      for (int g4 = 0; g4 < 4; ++g4) {
        const u32x2 az = azp[g4];
        const float y0 = oacc[dt][4 * g4] * inv * bflo(az[0]);
        const float y1 = oacc[dt][4 * g4 + 1] * inv * bfhi(az[0]);
        const float y2 = oacc[dt][4 * g4 + 2] * inv * bflo(az[1]);
        const float y3 = oacc[dt][4 * g4 + 3] * inv * bfhi(az[1]);
        ob[g4][0] = pack2(y0, y1); ob[g4][1] = pack2(y2, y3);
      }
      store_pair16(ym + qtoken * 1024 + h * 64 + dt * 32, ob[0], ob[1], hh);
      store_pair16(ym + qtoken * 1024 + h * 64 + dt * 32 + 16, ob[2], ob[3], hh);
    }
  }
}

DI void mlstm_out_item(const Params& p, int it) {
  const int lane = tid_l() & 63, r = lane & 31, hh = lane >> 5;
  const int bh = it >> 7, c = (it >> 1) & 63, tt = it & 1;
  const int b = bh >> 2, h = bh & 3;
  const size_t tok0 = (size_t)b * 4096 + c * 64;
  const bfu* proj = (const bfu*)(p.ws + OFF_PROJ);
  const bfu* qm = (const bfu*)(p.ws + OFF_QM);
  const bfu* km = (const bfu*)(p.ws + OFF_KM);
  const bfu* vm = (const bfu*)(p.ws + OFF_VM);
  const bfu* xcb = (const bfu*)(p.ws + OFF_XC);
  const bfu* cst = (const bfu*)(p.ws + OFF_UST) + (size_t)(bh * 64 + c) * 129 * 128;
  const float* cumv = (const float*)(p.ws + OFF_CUM) + (size_t)bh * 4096 + c * 64;
  const float* agv = (const float*)(p.ws + OFF_AG) + (size_t)bh * 4096 + c * 64;
  bfu* ym = (bfu*)(p.ws + OFF_HBUF);
  {
    const size_t token = tok0 + 32 * tt + r;
    u32x4 qf[8];
#pragma unroll
    for (int kk = 0; kk < 8; ++kk) qf[kk] = *(const u32x4*)(qm + token * 512 + h * 128 + 16 * kk + 8 * hh);
    const float cum_t = cumv[32 * tt + r];
    const float e_t = __expf(cum_t);
    float dn;
    {
      f32x16 an;
#pragma unroll
      for (int i = 0; i < 16; ++i) an[i] = 0.f;
#pragma unroll
      for (int kk = 0; kk < 8; ++kk) {
        u32x4 cv = {0u, 0u, 0u, 0u};
        if (r == 0) cv = *(const u32x4*)(cst + (size_t)128 * 128 + 16 * kk + 8 * hh);
        an = MFMA(as_frag(cv), as_frag(qf[kk]), an);
      }
      dn = __shfl(an[0], r);
    }
    f32x16 ai[4];
#pragma unroll
    for (int vt = 0; vt < 4; ++vt) {
#pragma unroll
      for (int i = 0; i < 16; ++i) ai[vt][i] = 0.f;
#pragma unroll
      for (int kk = 0; kk < 8; ++kk) {
        const u32x4 cv = *(const u32x4*)(cst + (size_t)(vt * 32 + r) * 128 + 16 * kk + 8 * hh);
        ai[vt] = MFMA(as_frag(cv), as_frag(qf[kk]), ai[vt]);
      }
#pragma unroll
      for (int i = 0; i < 16; ++i) ai[vt][i] *= e_t;
    }
    float den_i = 0.f;
#pragma unroll 1
    for (int st = 0; st <= tt; ++st) {
      f32x16 sacc;
#pragma unroll
      for (int i = 0; i < 16; ++i) sacc[i] = 0.f;
#pragma unroll
      for (int kk = 0; kk < 8; ++kk) {
        const bf16x8 kf = as_frag(*(const u32x4*)(km + (tok0 + 32 * st + r) * 512 + h * 128 + 16 * kk + 8 * hh));
        sacc = MFMA(kf, as_frag(qf[kk]), sacc);
      }
      const int tl = 32 * tt + r;
#pragma unroll
      for (int g4 = 0; g4 < 4; ++g4) {
        const float4 av = *(const float4*)(agv + 32 * st + 8 * g4 + 4 * hh);
        const float aa[4] = {av.x, av.y, av.z, av.w};
#pragma unroll
        for (int q = 0; q < 4; ++q) {
          const int s = 32 * st + 8 * g4 + 4 * hh + q;
          const float wgt = (s <= tl) ? sacc[4 * g4 + q] * __expf(cum_t + aa[q]) : 0.f;
          sacc[4 * g4 + q] = wgt;
          den_i += wgt;
        }
      }
#pragma unroll
      for (int ss = 0; ss < 2; ++ss) {
        u32x4 pk = {pack2(sacc[8 * ss], sacc[8 * ss + 1]), pack2(sacc[8 * ss + 2], sacc[8 * ss + 3]),
                    pack2(sacc[8 * ss + 4], sacc[8 * ss + 5]), pack2(sacc[8 * ss + 6], sacc[8 * ss + 7])};
        const bf16x8 pf = as_frag(pk);
#pragma unroll
        for (int vt = 0; vt < 4; ++vt) {
          const bfu* vp = vm + ((size_t)(bh * 64 + c) * 128 + vt * 32 + r) * 64 + 32 * st + 16 * ss + 4 * hh;
          const u32x2 lo = *(const u32x2*)vp;
          const u32x2 hi = *(const u32x2*)(vp + 8);
          u32x4 vv = {lo[0], lo[1], hi[0], hi[1]};
          ai[vt] = MFMA(as_frag(vv), pf, ai[vt]);
        }
      }
    }
    den_i += __shfl_xor(den_i, 32);
    const float den = den_i + e_t * dn;
    const float inv = 1.f / fmaxf(fabsf(den), 1.f);
    float s1 = 0.f;
#pragma unroll
    for (int vt = 0; vt < 4; ++vt)
#pragma unroll
      for (int i = 0; i < 16; ++i) {
        const float hv = ai[vt][i] * inv;
        ai[vt][i] = hv;
        s1 += hv;
      }
    s1 += __shfl_xor(s1, 32);
    const float mean = s1 * (1.f / 128.f);
    float s2 = 0.f;
#pragma unroll
    for (int vt = 0; vt < 4; ++vt)
#pragma unroll
      for (int i = 0; i < 16; ++i) { const float d = ai[vt][i] - mean; s2 += d * d; }
    s2 += __shfl_xor(s2, 32);
    const float rstd = rsqrtf(s2 * (1.f / 128.f) + 1e-5f);
#pragma unroll
    for (int vt = 0; vt < 4; ++vt) {
      u32x2 ob[4], xvp[4], zvp[4];
#pragma unroll
      for (int gp = 0; gp < 2; ++gp) {
        load_pair16(xcb + token * 512 + h * 128 + 32 * vt + 16 * gp, hh, xvp[2 * gp], xvp[2 * gp + 1]);
        load_pair16(proj + token * 3072 + 2560 + h * 128 + 32 * vt + 16 * gp, hh, zvp[2 * gp], zvp[2 * gp + 1]);
      }
#pragma unroll
      for (int g4 = 0; g4 < 4; ++g4) {
        const int v = 32 * vt + 8 * g4 + 4 * hh;
        const float4 og = *(const float4*)(p.out_g + h * 128 + v);
        const float4 sk = *(const float4*)(p.skip + h * 128 + v);
        const u32x2 xv = xvp[g4];
        const u32x2 zv = zvp[g4];
        const float y0 = ((ai[vt][4 * g4] - mean) * rstd * og.x + sk.x * bflo(xv[0])) * bflo(zv[0]);
        const float y1 = ((ai[vt][4 * g4 + 1] - mean) * rstd * og.y + sk.y * bfhi(xv[0])) * bfhi(zv[0]);
        const float y2 = ((ai[vt][4 * g4 + 2] - mean) * rstd * og.z + sk.z * bflo(xv[1])) * bflo(zv[1]);
        const float y3 = ((ai[vt][4 * g4 + 3] - mean) * rstd * og.w + sk.w * bfhi(xv[1])) * bfhi(zv[1]);
        ob[g4][0] = pack2(y0, y1); ob[g4][1] = pack2(y2, y3);
      }
      store_pair16(ym + token * 1024 + 512 + h * 128 + 32 * vt, ob[0], ob[1], hh);
      store_pair16(ym + token * 1024 + 512 + h * 128 + 32 * vt + 16, ob[2], ob[3], hh);
    }
  }
}

DI void sgu_item(const Params& p, int it, char* smem) {
  const int tid = tid_l(), lane = tid & 63, w = tid >> 6, r = lane & 31, hh = lane >> 5;
  const int g = it & 7, n = (it >> 3) & 31, b = it >> 8;
  const size_t tok0 = (size_t)b * 4096 + n * 128;
  float* sMu = (float*)smem;
  float* sRs = sMu + 128;
  if (tid < 128) {
    const float* st = (const float*)(p.ws + OFF_STATS) + (tok0 + tid) * 32;
    float s1 = 0.f, s2 = 0.f;
#pragma unroll
    for (int q = 0; q < 16; ++q) { s1 += st[2 * q]; s2 += st[2 * q + 1]; }
    const float mean = s1 * (1.f / 1024.f);
    const float var = fmaxf(s2 * (1.f / 1024.f) - mean * mean, 0.f);
    sMu[tid] = mean;
    sRs[tid] = rsqrtf(var + 1e-5f);
  }
  __syncthreads();
  const int cch = g * 128 + w * 32 + r;
  const float lng = p.c_ln_g[cch], lnb = p.c_ln_b[cch];
  const bfu* gvt = (const bfu*)(p.ws + OFF_GVT) + ((size_t)b * 1024 + cch) * 4096 + n * 128;
  const bfu* wsb = (const bfu*)(p.ws + OFF_WSB) + (size_t)g * 128 * 128;
  const bfu* proj = (const bfu*)(p.ws + OFF_PROJ);
  f32x16 acc[4];
#pragma unroll
  for (int tt = 0; tt < 4; ++tt)
#pragma unroll
    for (int i = 0; i < 16; ++i) acc[tt][i] = 0.f;
#pragma unroll
  for (int ks = 0; ks < 8; ++ks) {
    const u32x4 raw = *(const u32x4*)(gvt + 16 * ks + 8 * hh);
    float f[8];
#pragma unroll
    for (int q = 0; q < 4; ++q) { f[2 * q] = bflo(raw[q]); f[2 * q + 1] = bfhi(raw[q]); }
#pragma unroll
    for (int j = 0; j < 8; ++j) {
      const int s = 16 * ks + 8 * hh + j;
      f[j] = (f[j] - sMu[s]) * sRs[s] * lng + lnb;
    }
    u32x4 pk = {pack2(f[0], f[1]), pack2(f[2], f[3]), pack2(f[4], f[5]), pack2(f[6], f[7])};
    const bf16x8 af = as_frag(pk);
#pragma unroll
    for (int tt = 0; tt < 4; ++tt) {
      if (32 * tt + 31 >= 16 * ks) {
        const bf16x8 bfr = as_frag(*(const u32x4*)(wsb + (size_t)(32 * tt + r) * 128 + 16 * ks + 8 * hh));
        acc[tt] = MFMA(af, bfr, acc[tt]);
      }
    }
  }
  bfu* ym = (bfu*)(p.ws + OFF_HBUF);
#pragma unroll
  for (int tt = 0; tt < 4; ++tt) {
    const int t = 32 * tt + r;
    const size_t token = tok0 + t;
    const float bsv = p.c_bs[g * 128 + t];
    u32x2 ob[4], uvp[4], zvp[4];
#pragma unroll
    for (int gp = 0; gp < 2; ++gp) {
      load_pair16(proj + token * 3072 + g * 128 + w * 32 + 16 * gp, hh, uvp[2 * gp], uvp[2 * gp + 1]);
      load_pair16(proj + token * 3072 + 2048 + g * 128 + w * 32 + 16 * gp, hh, zvp[2 * gp], zvp[2 * gp + 1]);
    }
#pragma unroll
    for (int g4 = 0; g4 < 4; ++g4) {
      const u32x2 uv = uvp[g4];
      const u32x2 zv = zvp[g4];
      const float y0 = bflo(uv[0]) * (acc[tt][4 * g4] + bsv) * bflo(zv[0]);
      const float y1 = bfhi(uv[0]) * (acc[tt][4 * g4 + 1] + bsv) * bfhi(zv[0]);
      const float y2 = bflo(uv[1]) * (acc[tt][4 * g4 + 2] + bsv) * bflo(zv[1]);
      const float y3 = bfhi(uv[1]) * (acc[tt][4 * g4 + 3] + bsv) * bfhi(zv[1]);
      ob[g4][0] = pack2(y0, y1); ob[g4][1] = pack2(y2, y3);
    }
    store_pair16(ym + token * 1024 + g * 128 + w * 32, ob[0], ob[1], hh);
    store_pair16(ym + token * 1024 + g * 128 + w * 32 + 16, ob[2], ob[3], hh);
  }
  __syncthreads();
}

#ifndef ONLY_PH
#define ONLY_PH -1
#endif
#define PH_ON(x) (ONLY_PH < 0 || ONLY_PH == (x))
template <int ph>
DI void run_phase(const Params& pin, char* smem, bool rep) {
  const int G = gridDim.x, bid = blockIdx.x;
  if (!PH_ON(ph)) return;
  const Params& p = pin;
  switch (ph) {
    case 0: if (PH_ON(0)) {
      for (int it = bid; it < 1156; it += G) {
        if (it < 384) mod_item(p, it, (float*)smem);
        else if (it < 1152) { const int t = it - 384; transpose_tile(p.w_in, (bfu*)(p.ws + OFF_WTIN), 1024, 3072, (t & 15) * 64, (t >> 4) * 64, (float*)smem); }
        else gt_item(p, it - 1152);
      }
    } break;
    case 1: if (PH_ON(1))
      for (int it = bid; it < 512 + 96; it += G) { if (it < 512) norm_item(p, p.x, 0, it, (float*)smem); else modfin_item(p, it - 512); }
      break;
    case 2: if (PH_ON(2))
      if ((G & 7) == 0) {
        const int x = bid & 7;
        for (int lt = bid >> 3; lt < 192; lt += G >> 3)
          gemm_tile<0>(p, (const bfu*)(p.ws + OFF_HBUF), (const bfu*)(p.ws + OFF_WTIN), (x * 8 + lt / 24) * 256, (lt % 24) * 128, smem, 0, nullptr);
      } else {
        for (int t = bid; t < 64 * 24; t += G)
          gemm_tile<0>(p, (const bfu*)(p.ws + OFF_HBUF), (const bfu*)(p.ws + OFF_WTIN), (t / 24) * 256, (t % 24) * 128, smem, 0, nullptr);
      }
      break;
    case 3: if (PH_ON(3)) {
      const bool split = (G >= 512);
      for (int it = bid; it < 1600; it += (split ? (bid < 256 ? 1600 : G - 256) : G)) {
        if (it < 256) mlstm_prep_item(p, it, smem);
        else if (it < 1024) { const int t = it - 256; transpose_tile(p.w_in + (size_t)1024 * 3072, (bfu*)(p.ws + OFF_WTIN), 1024, 3072, (t & 15) * 64, (t >> 4) * 64, (float*)smem); }
        else if (it < 1280) { const int t = it - 1024; transpose_tile(p.w_out, (bfu*)(p.ws + OFF_WTOUT0), 1024, 1024, (t & 15) * 64, (t >> 4) * 64, (float*)smem); }
        else if (it < 1536) { const int t = it - 1280; transpose_tile(p.w_out + 1024 * 1024, (bfu*)(p.ws + OFF_WTOUT1), 1024, 1024, (t & 15) * 64, (t >> 4) * 64, (float*)smem); }
        else wsb_item(p, it - 1536);
      }
    } break;
    case 4: if (PH_ON(4)) {
      for (int it = bid; it < 129; it += G) { if (!rep) scan_item(p, it); }
      if ((G & 7) == 0) {
        const int x = bid & 7, nl = G >> 3, local = bid >> 3;
        for (int rd = 0; rd * nl < 128; ++rd) {
          const int li = (rd & 1) ? (rd + 1) * nl - 1 - local : rd * nl + local;
          if (li >= 128 || li < 0) continue;
          const int jj = li >> 3, rem = li & 7;
          moba_item(p, (jj << 6) | ((rem >> 2) << 5) | (x * 4 + (rem & 3)), smem);
        }
      } else {
        for (int rd = 0; rd * G < 1024; ++rd) {
          const int pos = (rd & 1) ? (rd + 1) * G - 1 - bid : rd * G + bid;
          if (pos >= 1024) continue;
          moba_item(p, pos, smem);
        }
      }
    } break;
    case 5: if (PH_ON(5)) {
      const int gw = __builtin_amdgcn_readfirstlane(bid * 4 + (tid_l() >> 6));
      for (int it = gw; it < 2048; it += G * 4) mlstm_out_item(p, it);
    } break;
    case 6: if (PH_ON(6))
      if ((G & 7) == 0) {
        const int x = bid & 7;
        for (int lt = bid >> 3; lt < 64; lt += G >> 3)
          gemm_tile<1>(p, (const bfu*)(p.ws + OFF_HBUF), (const bfu*)(p.ws + OFF_WTOUT0), (x * 8 + lt / 8) * 256, (lt % 8) * 128, smem, 0, p.x);
      } else {
        for (int t = bid; t < 64 * 8; t += G)
          gemm_tile<1>(p, (const bfu*)(p.ws + OFF_HBUF), (const bfu*)(p.ws + OFF_WTOUT0), (t / 8) * 256, (t % 8) * 128, smem, 0, p.x);
      }
      break;
    case 7: if (PH_ON(7))
      for (int it = bid; it < 512; it += G) norm_item(p, p.out, 1, it, (float*)smem);
      break;
    case 8: if (PH_ON(8))
      if ((G & 7) == 0) {
        const int x = bid & 7;
        for (int lt = bid >> 3; lt < 192; lt += G >> 3)
          gemm_tile<2>(p, (const bfu*)(p.ws + OFF_HBUF), (const bfu*)(p.ws + OFF_WTIN), (x * 8 + lt / 24) * 256, (lt % 24) * 128, smem, 1, nullptr);
      } else {
        for (int t = bid; t < 64 * 24; t += G)
          gemm_tile<2>(p, (const bfu*)(p.ws + OFF_HBUF), (const bfu*)(p.ws + OFF_WTIN), (t / 24) * 256, (t % 24) * 128, smem, 1, nullptr);
      }
      break;
    case 9: if (PH_ON(9))
      for (int it = bid; it < 1024; it += G) sgu_item(p, it, smem);
      break;
    case 10: if (PH_ON(10))
      if ((G & 7) == 0) {
        const int x = bid & 7;
        for (int lt = bid >> 3; lt < 64; lt += G >> 3)
          gemm_tile<1>(p, (const bfu*)(p.ws + OFF_HBUF), (const bfu*)(p.ws + OFF_WTOUT1), (x * 8 + lt / 8) * 256, (lt % 8) * 128, smem, 1, p.out);
      } else {
        for (int t = bid; t < 64 * 8; t += G)
          gemm_tile<1>(p, (const bfu*)(p.ws + OFF_HBUF), (const bfu*)(p.ws + OFF_WTOUT1), (t / 8) * 256, (t % 8) * 128, smem, 1, p.out);
      }
      break;
    default: break;
  }
}


#define XB_TMO      128
#define XB_XCNT(j)  (256  + 64 * (j))
#define XB_XSUB(j)  (1280 + 64 * (j))
#define XB_XGEN(j)  (2304 + 64 * (j))
#define XB_TOP      3328
#define XB_TOPGEN   3392
#define XCD_BAR_WORDS 3456
#define XB_SPIN_CAP (1u << 18)
#define LAS __attribute__((address_space(3)))

__device__ __forceinline__ unsigned xb_ld(unsigned* p)              { return __hip_atomic_load(p, __ATOMIC_RELAXED, __HIP_MEMORY_SCOPE_AGENT); }
__device__ __forceinline__ unsigned xb_add(unsigned* p, unsigned v) { return __hip_atomic_fetch_add(p, v, __ATOMIC_RELAXED, __HIP_MEMORY_SCOPE_AGENT); }
__device__ __forceinline__ unsigned xb_xcc_id() { return (unsigned)__builtin_amdgcn_s_getreg((3 << 11) | 20) & 0xFu; }
#define XB_SPIN(cond, bar) do { unsigned _sp = 0; while (cond) { __builtin_amdgcn_s_sleep(1); \
    if ((++_sp & 255u) == 0u) { if (xb_ld(&(bar)[XB_TMO])) break; if (_sp > XB_SPIN_CAP) { atomicAdd(&(bar)[XB_TMO], 1u); break; } } } } while (0)

struct XcdBarrier {
    unsigned* bar; unsigned x;
    volatile LAS unsigned* st;
};

__device__ __forceinline__ XcdBarrier xcd_barrier_post(unsigned* bar, volatile LAS unsigned* st) {
    XcdBarrier b; b.bar = bar; b.x = xb_xcc_id(); b.st = st;
    if (threadIdx.x == 0) (void)xb_add(&bar[XB_XCNT(b.x)], 1u);
    return b;
}
__device__ __forceinline__ void xcd_barrier_complete(unsigned* bar, unsigned x, unsigned& nloc, unsigned& nx) {
    const unsigned G = gridDim.x * gridDim.y * gridDim.z;
    unsigned sum, cnt, mine, sp = 0u;
    for (;;) {
        sum = 0u; cnt = 0u; mine = 0u;
#pragma unroll
        for (unsigned j = 0; j < 16; ++j) { const unsigned c = xb_ld(&bar[XB_XCNT(j)]); sum += c; cnt += (c > 0u) ? 1u : 0u; mine = (j == x) ? c : mine; }
        if (sum == G) break;
        __builtin_amdgcn_s_sleep(1);
        if ((++sp & 255u) == 0u) { if (xb_ld(&bar[XB_TMO])) break; if (sp > XB_SPIN_CAP) { atomicAdd(&bar[XB_TMO], 1u); break; } }
    }
    nloc = mine > 0u ? mine : 1u; nx = cnt > 0u ? cnt : 1u;
}

__device__ __forceinline__ void xcd_barrier(const XcdBarrier& b) {
    asm volatile("s_waitcnt vmcnt(0)" ::: "memory");
    __syncthreads();
    if (threadIdx.x == 0) {
        unsigned* bar = b.bar;
        __builtin_amdgcn_s_waitcnt(0);
        unsigned nloc = b.st[0], nx = b.st[1];
        if (nloc == 0u) { xcd_barrier_complete(bar, b.x, nloc, nx); b.st[0] = nloc; b.st[1] = nx; }
        const unsigned old = xb_add(&bar[XB_XSUB(b.x)], 1u);
        const unsigned gen = old / nloc;
        if (old + 1u == (gen + 1u) * nloc) {
            __builtin_amdgcn_fence(__ATOMIC_RELEASE, "agent");
            asm volatile("s_waitcnt vmcnt(0)" ::: "memory");
            const unsigned og = xb_add(&bar[XB_TOP], 1u);
            const unsigned tg = og / nx;
            if (og + 1u == (tg + 1u) * nx) xb_add(&bar[XB_TOPGEN], 1u);
            else XB_SPIN(xb_ld(&bar[XB_TOPGEN]) == tg, bar);
            __builtin_amdgcn_fence(__ATOMIC_ACQUIRE, "agent");
            xb_add(&bar[XB_XGEN(b.x)], 1u);
            asm volatile("s_waitcnt vmcnt(0)" ::: "memory");
        } else {
            XB_SPIN(xb_ld(&bar[XB_XGEN(b.x)]) == gen, bar);
            __builtin_amdgcn_fence(__ATOMIC_ACQUIRE, "agent");
            asm volatile("s_waitcnt vmcnt(0)" ::: "memory");
        }
    }
    __syncthreads();
}


constexpr int NPHASE = 11;

__global__ void __launch_bounds__(256, 2) fwd_mega(Params p, int never) {
  __shared__ __attribute__((aligned(16))) char smem[65536];
  cg::grid_group grid = cg::this_grid();
  if (never < 0) grid.sync();
  __shared__ uint4 xb_words;
  if (threadIdx.x == 0) xb_words = make_uint4(0u, 0u, 0u, 0u);
  __syncthreads();
  XcdBarrier xb = xcd_barrier_post((unsigned*)(p.ws + OFF_BAR), (volatile LAS unsigned*)&xb_words);
#ifndef REP_PH
#define REP_PH -1
#endif
#define PHASE(n)                                                      \
  run_phase<n>(p, smem, false);                                       \
  if (REP_PH == n) { xcd_barrier(xb); run_phase<n>(p, smem, true); }  \
  if (n + 1 < NPHASE) xcd_barrier(xb);
  PHASE(0) PHASE(1) PHASE(2) PHASE(3) PHASE(4) PHASE(5) PHASE(6) PHASE(7) PHASE(8) PHASE(9) PHASE(10)
}

extern "C" void kernel_launch(void* const* d_in, const int* in_sizes, int n_in, void* d_out, int out_size, void* d_ws,
                              size_t ws_size, hipStream_t stream) {
  Params p{};
  p.x = (const float*)d_in[0]; p.c = (const float*)d_in[1]; p.ln_g = (const float*)d_in[2];
  p.ada_w = (const float*)d_in[3]; p.ada_b = (const float*)d_in[4]; p.w_in = (const float*)d_in[5];
  p.w_out = (const float*)d_in[6]; p.a_q_g = (const float*)d_in[7]; p.a_k_g = (const float*)d_in[8];
  p.conv_w = (const float*)d_in[9]; p.conv_b = (const float*)d_in[10]; p.wq = (const float*)d_in[11];
  p.wk = (const float*)d_in[12]; p.wv = (const float*)d_in[13]; p.w_gates = (const float*)d_in[14];
  p.b_gates = (const float*)d_in[15]; p.out_g = (const float*)d_in[16]; p.skip = (const float*)d_in[17];
  p.c_ln_g = (const float*)d_in[18]; p.c_ln_b = (const float*)d_in[19]; p.c_ws = (const float*)d_in[20];
  p.c_bs = (const float*)d_in[21];
  p.out = (float*)d_out;
  p.ws = (char*)d_ws;
  static int grid_blocks = 0;
  if (!grid_blocks) {
    int dev = 0, cus = 0, per_cu = 0;
    hipGetDevice(&dev);
    hipDeviceGetAttribute(&cus, hipDeviceAttributeMultiprocessorCount, dev);
    hipOccupancyMaxActiveBlocksPerMultiprocessor(&per_cu, fwd_mega, 256, 0);
    if (per_cu > 2) per_cu = 2;
    if (per_cu < 1) per_cu = 1;
    grid_blocks = cus * per_cu;
  }
  hipMemsetAsync((char*)d_ws + OFF_BAR, 0, XCD_BAR_WORDS * 4, stream);
  int never = 0;
  void* args[] = {&p, &never};
  hipError_t e = hipLaunchCooperativeKernel((void*)fwd_mega, dim3(grid_blocks), dim3(256), args, 0, stream);
  if (e != hipSuccess) fprintf(stderr, "cooperative launch failed: %s (grid %d)\n", hipGetErrorString(e), grid_blocks);
}
```
